# Optimizing an MI355X kernel written in HIP

```python
import math
import jax, jax.numpy as jnp
from jax import lax
import numpy as np

D_MODEL = 1024
BATCH = 2
SEQ = 8192
DEPTH = 2

HEAD_DIM = 64
N_HEADS_DSWA = 8
DSWA_GROUPS = ((128, 1), (512, 4), (2048, 16))
N_HEADS_DIFF = 4
DIFF_VDIM = 2 * HEAD_DIM
WIDTH_DSWA = N_HEADS_DSWA * HEAD_DIM
WIDTH_DIFF = N_HEADS_DIFF * DIFF_VDIM
MIX_WIDTH = WIDTH_DSWA + WIDTH_DIFF
IN_SPLITS = (WIDTH_DSWA,) * 4 + (WIDTH_DIFF,) * 4
IN_COLS = sum(IN_SPLITS)
ROPE_THETA = 500000.0
ROPE_DIM = HEAD_DIM // 4
PLE_DIM = 256
Q_BLOCK = 128
RMS_EPS = 1e-6
SUBLN_EPS = 1e-5

kernel_name = "hymba_dswa_diffattn_ple"


def rmsnorm(x, g, eps=RMS_EPS):
    xf = x.astype(jnp.float32)
    y = xf * lax.rsqrt(jnp.mean(xf * xf, axis=-1, keepdims=True) + eps)
    return (y * g.astype(jnp.float32)).astype(x.dtype)


def rope_partial(x, pos):
    half = ROPE_DIM // 2
    inv = jnp.power(ROPE_THETA, -jnp.arange(half, dtype=jnp.float32) * (2.0 / ROPE_DIM))
    ang = pos.astype(jnp.float32)[:, None] * inv[None, :]
    cos, sin = jnp.cos(ang), jnp.sin(ang)
    xr = x[..., :ROPE_DIM].astype(jnp.float32)
    x1, x2 = xr[..., :half], xr[..., half:]
    rot = jnp.concatenate([x1 * cos - x2 * sin, x2 * cos + x1 * sin], axis=-1).astype(x.dtype)
    return jnp.concatenate([rot, x[..., ROPE_DIM:]], axis=-1)


def dilated_window_group(q, k, v, window, dilation):
    b, h, s, dh = q.shape
    w = window // dilation
    unit = w * dilation
    sp = -(-s // unit) * unit
    L = sp // dilation
    nb = L // w

    def to_blocks(t):
        t = jnp.pad(t, ((0, 0), (0, 0), (0, sp - s), (0, 0)))
        t = t.reshape(b, h, L, dilation, dh).swapaxes(2, 3)
        return t.reshape(b, h, dilation, nb, w, dh)

    def with_prev(t):
        prev = jnp.pad(t[:, :, :, :-1], ((0, 0), (0, 0), (0, 0), (1, 0), (0, 0), (0, 0)))
        return jnp.concatenate([prev, t], axis=4)

    qb = to_blocks(q)
    kc = with_prev(to_blocks(k))
    vc = with_prev(to_blocks(v))
    sc = jnp.einsum('bhrnqd,bhrnkd->bhrnqk', qb, kc).astype(jnp.float32) * (dh ** -0.5)
    i = jnp.arange(w)[:, None]
    j = jnp.arange(2 * w)[None, :]
    dist = w + i - j
    band = (dist >= 0) & (dist <= w)
    mask = band[None] & ((jnp.arange(nb)[:, None, None] > 0) | (j >= w)[None])
    sc = jnp.where(mask, sc, -jnp.inf)
    m = jnp.max(sc, axis=-1, keepdims=True)
    e = jnp.exp(sc - m)
    den = jnp.sum(e, axis=-1)
    o = jnp.einsum('bhrnqk,bhrnkd->bhrnqd', e, vc.astype(jnp.float32)) / den[..., None]
    lse = m[..., 0] + jnp.log(den)

    def from_blocks(t):
        rest = t.shape[5:]
        t = t.reshape((b, h, dilation, L) + rest).swapaxes(2, 3)
        return t.reshape((b, h, sp) + rest)[:, :, :s]

    return from_blocks(o), from_blocks(lse)


def dilated_attention(q, k, v):
    outs, lses = [], []
    for window, dilation in DSWA_GROUPS:
        o, lse = dilated_window_group(q, k, v, window, dilation)
        outs.append(o)
        lses.append(lse)
    wts = jax.nn.softmax(jnp.stack(lses, axis=0), axis=0)
    return jnp.sum(wts[..., None] * jnp.stack(outs, axis=0), axis=0).astype(q.dtype)


def diff_attention(q, k, v, lam, lambda_init, subln_gain):
    b, h, _, s, dh = q.shape
    nq = s // Q_BLOCK
    qb = q.reshape(b, h, 2, nq, Q_BLOCK, dh).transpose(3, 0, 1, 2, 4, 5)
    kpos = jnp.arange(s)

    def block(args):
        qblk, idx = args
        qpos = idx * Q_BLOCK + jnp.arange(Q_BLOCK)
        sc = jnp.einsum('bhcqd,bhckd->bhcqk', qblk, k).astype(jnp.float32) * (dh ** -0.5)
        causal = kpos[None, :] <= qpos[:, None]
        pr = jax.nn.softmax(jnp.where(causal, sc, -jnp.inf), axis=-1)
        a = pr[:, :, 0] - lam * pr[:, :, 1]
        return jnp.einsum('bhqk,bhkd->bhqd', a.astype(v.dtype), v)

    o = lax.map(block, (qb, jnp.arange(nq)))
    o = o.transpose(1, 2, 0, 3, 4).reshape(b, h, s, DIFF_VDIM)
    return rmsnorm(o, subln_gain, SUBLN_EPS) * (1.0 - lambda_init)


def hybrid_layer(h, p_i, layer_idx, norm_gain, w_in, w_out, lq1, lk1, lq2, lk2,
                 subln_gain, ple_norm_gain, w_ple_gate, w_ple):
    b, s, _ = h.shape
    pos = jnp.arange(s)
    u = rmsnorm(h, norm_gain) @ w_in
    qa, ka, va, ga, qd, kd, vd, gd = jnp.split(u, list(np.cumsum(IN_SPLITS)[:-1]), axis=-1)

    def heads_a(t):
        return t.reshape(b, s, N_HEADS_DSWA, HEAD_DIM).transpose(0, 2, 1, 3)
    qa_h = rope_partial(heads_a(qa), pos)
    ka_h = rope_partial(heads_a(ka), pos)
    oa = dilated_attention(qa_h, ka_h, heads_a(va))
    oa = oa.transpose(0, 2, 1, 3).reshape(b, s, WIDTH_DSWA)

    def heads_b(t):
        return t.reshape(b, s, N_HEADS_DIFF, 2, HEAD_DIM).transpose(0, 2, 3, 1, 4)
    qd_h = rope_partial(heads_b(qd), pos)
    kd_h = rope_partial(heads_b(kd), pos)
    vd_h = vd.reshape(b, s, N_HEADS_DIFF, DIFF_VDIM).transpose(0, 2, 1, 3)
    lambda_init = 0.8 - 0.6 * math.exp(-0.3 * layer_idx)
    lam = (jnp.exp(jnp.sum(lq1.astype(jnp.float32) * lk1.astype(jnp.float32)))
           - jnp.exp(jnp.sum(lq2.astype(jnp.float32) * lk2.astype(jnp.float32)))
           + lambda_init)
    od = diff_attention(qd_h, kd_h, vd_h, lam, lambda_init, subln_gain)
    od = od.transpose(0, 2, 1, 3).reshape(b, s, WIDTH_DIFF)

    y = jnp.concatenate([oa * jax.nn.silu(ga), od * jax.nn.silu(gd)], axis=-1) @ w_out
    h = h + y

    gate = jax.nn.sigmoid(rmsnorm(h, ple_norm_gain) @ w_ple_gate)
    return h + (p_i @ w_ple) * gate


def setup_inputs(seed: int = 0) -> dict:
    key = jax.random.key(seed)
    ks = jax.random.split(key, 16)
    f32 = jnp.float32
    nrm = lambda k, shape, scale: jax.random.normal(k, shape, f32) * scale
    return {
        "x": nrm(ks[0], (BATCH, SEQ, D_MODEL), 1.0),
        "p": nrm(ks[1], (DEPTH, BATCH, SEQ, PLE_DIM), 1.0),
        "attn_norm_gain": 1.0 + nrm(ks[2], (DEPTH, D_MODEL), 0.02),
        "w_in": nrm(ks[3], (DEPTH, D_MODEL, IN_COLS), D_MODEL ** -0.5),
        "w_out": nrm(ks[4], (DEPTH, MIX_WIDTH, D_MODEL), MIX_WIDTH ** -0.5),
        "lambda_q1": nrm(ks[5], (DEPTH, HEAD_DIM), 0.1),
        "lambda_k1": nrm(ks[6], (DEPTH, HEAD_DIM), 0.1),
        "lambda_q2": nrm(ks[7], (DEPTH, HEAD_DIM), 0.1),
        "lambda_k2": nrm(ks[8], (DEPTH, HEAD_DIM), 0.1),
        "subln_gain": 1.0 + nrm(ks[9], (DEPTH, DIFF_VDIM), 0.02),
        "ple_norm_gain": 1.0 + nrm(ks[10], (DEPTH, D_MODEL), 0.02),
        "w_ple_gate": nrm(ks[11], (DEPTH, D_MODEL, D_MODEL), D_MODEL ** -0.5),
        "w_ple": nrm(ks[12], (DEPTH, PLE_DIM, D_MODEL), 0.5 * PLE_DIM ** -0.5),
        "final_norm_gain": 1.0 + nrm(ks[13], (D_MODEL,), 0.02),
    }


def reference(x, p, attn_norm_gain, w_in, w_out, lambda_q1, lambda_k1, lambda_q2,
              lambda_k2, subln_gain, ple_norm_gain, w_ple_gate, w_ple, final_norm_gain):
    h = x
    for i in range(DEPTH):
        h = hybrid_layer(h, p[i], i, attn_norm_gain[i], w_in[i], w_out[i],
                         lambda_q1[i], lambda_k1[i], lambda_q2[i], lambda_k2[i],
                         subln_gain[i], ple_norm_gain[i], w_ple_gate[i], w_ple[i])
    return rmsnorm(h, final_norm_gain)
```

```cpp
#include <hip/hip_runtime.h>
#include <hip/hip_cooperative_groups.h>
#include <cstdio>
#include <cstdint>
#include <type_traits>
namespace pg8 {
#define PG8_LAS __attribute__((address_space(3)))
typedef unsigned short bf16_t;
typedef short bf16x8 __attribute__((ext_vector_type(8)));
typedef float f32x4 __attribute__((ext_vector_type(4)));
typedef unsigned u32x4 __attribute__((ext_vector_type(4)));
constexpr int BM = 256, BK = 64, HALF = 128, HTB = HALF * BK * 2  , STAGE_BYTES = 8 * HTB, NXCD = 8, WGM = 8;

__host__ __device__ __forceinline__ int lds_byte(int r, int c) { const int st = (r >> 4) * 2 + (c >> 5), rr = r & 15, cc = c & 31, ob = rr * 64 + cc * 2; return st * 1024 + (ob ^ (((ob >> 9) & 1) << 5)); }
__host__ __device__ __forceinline__ void stage_rc(int b, int& R, int& C) { const int st = b / 1024, sb = b % 1024, swz = sb ^ (((sb >> 9) & 1) << 5); R = (st >> 1) * 16 + swz / 64; C = (st & 1) * 32 + (swz % 64) / 2; }
__host__ __device__ __forceinline__ int perm32(int rho) { const int n = rho >> 4, i = rho & 15; return 8 * (i >> 2) + 4 * n + (i & 3); }

struct Unit { int pm, pn; };
struct Gemm { const bf16_t* A; const bf16_t* Bt; int M, N, K; };

struct StaticOrder {
    int nM, nN, nwg, G, c;
    __host__ __device__ void init(int M, int N, int G_, int c_) { nM = M / BM; nN = N / BM; nwg = nM * nN; G = G_; c = c_; }
    __host__ __device__ bool next(int i, Unit& u) const {
        const long L = (long)i * G + c; if (L >= nwg) return false;
        int wgid = (int)L; { const int q = nwg / NXCD, r = nwg % NXCD, xcd = wgid % NXCD, off = wgid / NXCD; wgid = (xcd < r ? xcd * (q + 1) : r * (q + 1) + (xcd - r) * q) + off; }
        const int nig = WGM * nN, gid = wgid / nig, fm = gid * WGM, gsz = (nM - fm) < WGM ? (nM - fm) : WGM;
        u.pm = fm + ((wgid % nig) % gsz); u.pn = (wgid % nig) / gsz; return true;
    }
    __device__ __forceinline__ void a_ready(const Unit&) const {}
    __device__ __forceinline__ void done(const Unit&) const {}
};

__device__ __forceinline__ unsigned cvt_pk_bf16(float lo, float hi) { unsigned r; asm volatile("v_cvt_pk_bf16_f32 %0, %1, %2" : "=v"(r) : "v"(lo), "v"(hi)); return r; }
typedef float f32x2 __attribute__((ext_vector_type(2)));
__device__ __forceinline__ f32x2 gelu_pk(f32x2 v) {
    const f32x2 av = __builtin_elementwise_abs(v), d = av * 0.2316418882f + 1.0f;
    f32x2 t; t.x = __builtin_amdgcn_rcpf(d.x); t.y = __builtin_amdgcn_rcpf(d.y);
    f32x2 q = t * 0.5307027145f + (-0.7265760135f); q = q * t + 0.7107068705f; q = q * t + (-0.142248368f); q = q * t + 0.127414796f; q = q * t;
    const f32x2 s = (v * v) * (-0.72134752044f);
    f32x2 e; e.x = __builtin_amdgcn_exp2f(s.x); e.y = __builtin_amdgcn_exp2f(s.y);
    const f32x2 m = v * (q * e), r = v - m;
    f32x2 o; o.x = v.x < 0.f ? m.x : r.x; o.y = v.y < 0.f ? m.y : r.y; return o;
}

template <int ACT  > struct EpiBf16 {
    static constexpr bool PERM = true, AFTER_DRAIN = false; static_assert(ACT == 0 || ACT == 1, "EpiBf16: ACT is 0 (none) or 1 (gelu_pk)");
    bf16_t* O; int ldc; const float* bias; int split_cols; size_t split_stride; float scale0;
    __device__ __forceinline__ void operator()(const f32x4 (&acc)[2][2][4][2], const Unit& u, int wr, int wc, int fr, int fq) const {
        const int row0 = u.pm * BM + wr * 64 + fr; int colt = u.pn * BM; bf16_t* base = O;
        float sc = 1.f; if (split_cols) { const int t = colt / split_cols; base += (size_t)t * split_stride; colt -= t * split_cols; if (t == 0) sc = scale0; }
        const int col0 = colt + wc * 32 + 8 * fq, bcol0 = u.pn * BM + wc * 32 + 8 * fq;
        f32x4 bv[2][2];
#pragma unroll
        for (int bj = 0; bj < 2; ++bj)
#pragma unroll
            for (int n = 0; n < 2; ++n) bv[bj][n] = bias ? *(const f32x4*)(bias + bcol0 + bj * HALF + 4 * n) : (f32x4){0.f, 0.f, 0.f, 0.f};
#pragma unroll
        for (int ai = 0; ai < 2; ++ai)
#pragma unroll
            for (int m = 0; m < 4; ++m) { bf16_t* rowp = base + (size_t)(row0 + ai * HALF + m * 16) * ldc + col0;
#pragma unroll
                for (int bj = 0; bj < 2; ++bj) { f32x4 v0 = acc[ai][bj][m][0] + bv[bj][0], v1 = acc[ai][bj][m][1] + bv[bj][1];
                    if (ACT == 1) { f32x2 a = gelu_pk((f32x2){v0[0], v0[1]}), b = gelu_pk((f32x2){v0[2], v0[3]}), c = gelu_pk((f32x2){v1[0], v1[1]}), d = gelu_pk((f32x2){v1[2], v1[3]});
                        v0 = (f32x4){a.x, a.y, b.x, b.y}; v1 = (f32x4){c.x, c.y, d.x, d.y}; }
                    v0 = v0 * sc; v1 = v1 * sc; u32x4 w; w.x = cvt_pk_bf16(v0[0], v0[1]); w.y = cvt_pk_bf16(v0[2], v0[3]); w.z = cvt_pk_bf16(v1[0], v1[1]); w.w = cvt_pk_bf16(v1[2], v1[3]);
                    *(u32x4*)(rowp + bj * HALF) = w; } }
    }
};

__device__ __forceinline__ float ssq16(const float* p) { const f32x4 a = ((const f32x4*)p)[0], b = ((const f32x4*)p)[1], c = ((const f32x4*)p)[2], d = ((const f32x4*)p)[3];
    return (((a[0] + a[1]) + (a[2] + a[3])) + ((b[0] + b[1]) + (b[2] + b[3]))) + (((c[0] + c[1]) + (c[2] + c[3])) + ((d[0] + d[1]) + (d[2] + d[3]))); }
__device__ __forceinline__ float rstd_of(const float* p) { return __builtin_amdgcn_rsqf(ssq16(p) * (1.0f / 1024.0f) + 1e-6f); }
__device__ __forceinline__ float sigm(float x) { return __builtin_amdgcn_rcpf(1.0f + __builtin_amdgcn_exp2f(-1.4426950408889634f * x)); }
constexpr float QSCALE = 0.125f * 1.4426950408889634f;
struct EpiQKVG {
    static constexpr bool PERM = true, AFTER_DRAIN = false;
    bf16_t* U; bf16_t* GATE; const PG8_LAS float* rsl; const PG8_LAS float* rope;
    __device__ __forceinline__ void operator()(const f32x4 (&acc)[2][2][4][2], const Unit& u, int wr, int wc, int fr, int fq) const {
        const int type = u.pn >> 1, t3 = type & 3;
        const bool isg = t3 == 3, isq = t3 == 0;
        bf16_t* base; int ld, colt;
        if (isg) { base = GATE; ld = 1024; colt = (type >> 2) * 512 + (u.pn & 1) * 256; }
        else { base = U; ld = 3072; colt = ((type >> 2) * 3 + t3) * 512 + (u.pn & 1) * 256; }
        const int col0 = colt + wc * 32 + 8 * fq;
        const bool ropew = (t3 <= 1) && ((wc & 1) == 0);
#pragma unroll
        for (int ai = 0; ai < 2; ++ai)
#pragma unroll
            for (int m = 0; m < 4; ++m) {
                if ((m & 1) == 0) asm volatile("" ::: "memory");
                const int row = u.pm * BM + wr * 64 + ai * HALF + m * 16 + fr;
                const float rs = rsl[wr * 64 + ai * HALF + m * 16 + fr];
                const float sc = isq ? rs * QSCALE : rs;
                f32x4 c0 = {1.f, 1.f, 1.f, 1.f}, c1 = c0, s0 = {0.f, 0.f, 0.f, 0.f}, s1 = s0;
                if (ropew) { const PG8_LAS f32x4* rp = (const PG8_LAS f32x4*)(rope + (wr * 64 + ai * HALF + m * 16 + fr) * 16); c0 = rp[0]; c1 = rp[1]; s0 = rp[2]; s1 = rp[3]; if (fq == 0) { s0 = -s0; s1 = -s1; } if (fq > 1) { s0 = (f32x4){0.f,0.f,0.f,0.f}; s1 = s0; c0 = (f32x4){1.f,1.f,1.f,1.f}; c1 = c0; } }
                bf16_t* rowp = base + (size_t)row * ld + col0;
#pragma unroll
                for (int bj = 0; bj < 2; ++bj) {
                    f32x4 v0 = acc[ai][bj][m][0] * sc, v1 = acc[ai][bj][m][1] * sc;
                    if (ropew) {
                        f32x4 p0, p1;
#pragma unroll
                        for (int i = 0; i < 4; ++i) { p0[i] = __shfl_xor(v0[i], 16); p1[i] = __shfl_xor(v1[i], 16); }
                        v0 = v0 * c0 + p0 * s0; v1 = v1 * c1 + p1 * s1;
                    }
                    if (isg) {
#pragma unroll
                        for (int i = 0; i < 4; ++i) { v0[i] = v0[i] * sigm(v0[i]); v1[i] = v1[i] * sigm(v1[i]); }
                    }
                    u32x4 w; w.x = cvt_pk_bf16(v0[0], v0[1]); w.y = cvt_pk_bf16(v0[2], v0[3]); w.z = cvt_pk_bf16(v1[0], v1[1]); w.w = cvt_pk_bf16(v1[2], v1[3]);
                    *(u32x4*)(rowp + bj * HALF) = w;
                }
            }
    }
};
typedef unsigned u32x2 __attribute__((ext_vector_type(2)));
__device__ __forceinline__ f32x4 bf4(u32x2 e) { f32x4 r; r[0] = __uint_as_float(e.x << 16); r[1] = __uint_as_float(e.x & 0xffff0000u); r[2] = __uint_as_float(e.y << 16); r[3] = __uint_as_float(e.y & 0xffff0000u); return r; }
template <bool HIN_F32> struct EpiRes {
    static constexpr bool PERM = false, AFTER_DRAIN = false;
    const float* hin32; const bf16_t* hin16; bf16_t* hb; float* ssq;
    __device__ __forceinline__ void operator()(const f32x4 (&acc)[2][2][4][2], const Unit& u, int wr, int wc, int fr, int fq) const {
        const int col0 = u.pn * BM + wc * 32 + 4 * fq;
#pragma unroll
        for (int ai = 0; ai < 2; ++ai) {
            asm volatile("" ::: "memory");
            f32x4 hv[4][2][2];
#pragma unroll
            for (int m = 0; m < 4; ++m) { const size_t off = (size_t)(u.pm * BM + wr * 64 + ai * HALF + m * 16 + fr) * 1024 + col0;
#pragma unroll
                for (int bj = 0; bj < 2; ++bj)
#pragma unroll
                    for (int n = 0; n < 2; ++n) { if (HIN_F32) hv[m][bj][n] = *(const f32x4*)(hin32 + off + bj * HALF + 16 * n); else hv[m][bj][n] = bf4(*(const u32x2*)(hin16 + off + bj * HALF + 16 * n)); } }
#pragma unroll
            for (int m = 0; m < 4; ++m) {
                const int row = u.pm * BM + wr * 64 + ai * HALF + m * 16 + fr;
                const size_t off = (size_t)row * 1024 + col0; float part = 0.f;
#pragma unroll
                for (int bj = 0; bj < 2; ++bj)
#pragma unroll
                    for (int n = 0; n < 2; ++n) {
                        const f32x4 v = hv[m][bj][n] + acc[ai][bj][m][n];
                        part += (v[0] * v[0] + v[1] * v[1]) + (v[2] * v[2] + v[3] * v[3]);
                        u32x2 w; w.x = cvt_pk_bf16(v[0], v[1]); w.y = cvt_pk_bf16(v[2], v[3]);
                        *(u32x2*)(hb + off + bj * HALF + 16 * n) = w;
                    }
                part += __shfl_xor(part, 16); part += __shfl_xor(part, 32);
                if (fq == 0) ssq[(size_t)row * 16 + u.pn * 4 + wc] = part;
            }
        }
    }
};
struct EpiE {
    static constexpr bool PERM = true, AFTER_DRAIN = false;
    bf16_t* E;
    __device__ __forceinline__ void operator()(const f32x4 (&acc)[2][2][4][2], const Unit& u, int wr, int wc, int fr, int fq) const {
        const int col0 = u.pn * BM + wc * 32 + 8 * fq;
#pragma unroll
        for (int ai = 0; ai < 2; ++ai)
#pragma unroll
            for (int m = 0; m < 4; ++m) {
                const int row = u.pm * BM + wr * 64 + ai * HALF + m * 16 + fr;
#pragma unroll
                for (int bj = 0; bj < 2; ++bj) { const f32x4 v0 = acc[ai][bj][m][0], v1 = acc[ai][bj][m][1];
                    u32x4 w; w.x = cvt_pk_bf16(v0[0], v0[1]); w.y = cvt_pk_bf16(v0[2], v0[3]); w.z = cvt_pk_bf16(v1[0], v1[1]); w.w = cvt_pk_bf16(v1[2], v1[3]);
                    *(u32x4*)(E + (size_t)row * 1024 + col0 + bj * HALF) = w; }
            }
    }
};
__device__ __forceinline__ float rstd_q(const float* p, int fq) {
    const f32x4 a = ((const f32x4*)p)[fq]; float s = (a[0] + a[1]) + (a[2] + a[3]); s += __shfl_xor(s, 16); s += __shfl_xor(s, 32);
    return __builtin_amdgcn_rsqf(s * (1.0f / 1024.0f) + 1e-6f); }
struct EpiPle {
    static constexpr bool PERM = false, AFTER_DRAIN = false;
    const bf16_t* H; const bf16_t* E; bf16_t* hb; const float* ssq_in; float* ssq_out;
    __device__ __forceinline__ void operator()(const f32x4 (&acc)[2][2][4][2], const Unit& u, int wr, int wc, int fr, int fq) const {
        const int col0 = u.pn * BM + wc * 32 + 4 * fq;
#pragma unroll
        for (int ai = 0; ai < 2; ++ai) {
            asm volatile("" ::: "memory");
            u32x2 hv[4][2][2], ev[4][2][2]; float rs[4];
#pragma unroll
            for (int m = 0; m < 4; ++m) { const int row = u.pm * BM + wr * 64 + ai * HALF + m * 16 + fr; const size_t off = (size_t)row * 1024 + col0;
                rs[m] = rstd_q(ssq_in + (size_t)row * 16, fq);
#pragma unroll
                for (int bj = 0; bj < 2; ++bj)
#pragma unroll
                    for (int n = 0; n < 2; ++n) { hv[m][bj][n] = *(const u32x2*)(H + off + bj * HALF + 16 * n); ev[m][bj][n] = *(const u32x2*)(E + off + bj * HALF + 16 * n); } }
#pragma unroll
            for (int m = 0; m < 4; ++m) {
                const int row = u.pm * BM + wr * 64 + ai * HALF + m * 16 + fr;
                const size_t off = (size_t)row * 1024 + col0; float part = 0.f;
#pragma unroll
                for (int bj = 0; bj < 2; ++bj)
#pragma unroll
                    for (int n = 0; n < 2; ++n) {
                        const f32x4 a = bf4(hv[m][bj][n]), ef = bf4(ev[m][bj][n]);
                        f32x4 v;
#pragma unroll
                        for (int i = 0; i < 4; ++i) v[i] = a[i] + ef[i] * sigm(acc[ai][bj][m][n][i] * rs[m]);
                        part += (v[0] * v[0] + v[1] * v[1]) + (v[2] * v[2] + v[3] * v[3]);
                        u32x2 w; w.x = cvt_pk_bf16(v[0], v[1]); w.y = cvt_pk_bf16(v[2], v[3]);
                        *(u32x2*)(hb + off + bj * HALF + 16 * n) = w;
                    }
                part += __shfl_xor(part, 16); part += __shfl_xor(part, 32);
                if (fq == 0) ssq_out[(size_t)row * 16 + u.pn * 4 + wc] = part;
            }
        }
    }
};

struct EpiPleFinal {
    static constexpr bool PERM = false, AFTER_DRAIN = true;
    const bf16_t* H; const bf16_t* E; const float* ssq_in; float* ssq_out; unsigned* cnt; const float* gfin; float* out;
    __device__ __forceinline__ void fused(f32x4 (&acc)[2][2][4][2], const Unit& u, int wr, int wc, int fr, int fq, PG8_LAS unsigned char*, int, int lane) const {
        const int col0 = u.pn * BM + wc * 32 + 4 * fq;
#pragma unroll
        for (int ai = 0; ai < 2; ++ai)
#pragma unroll
            for (int m = 0; m < 4; ++m) {
                if ((m & 1) == 0) asm volatile("" ::: "memory");
                const int row = u.pm * BM + wr * 64 + ai * HALF + m * 16 + fr;
                const float rs = rstd_q(ssq_in + (size_t)row * 16, fq);
                const size_t off = (size_t)row * 1024 + col0; float part = 0.f;
#pragma unroll
                for (int bj = 0; bj < 2; ++bj)
#pragma unroll
                    for (int n = 0; n < 2; ++n) {
                        const f32x4 a = bf4(*(const u32x2*)(H + off + bj * HALF + 16 * n)), ef = bf4(*(const u32x2*)(E + off + bj * HALF + 16 * n));
                        f32x4 v;
#pragma unroll
                        for (int i = 0; i < 4; ++i) v[i] = a[i] + ef[i] * sigm(acc[ai][bj][m][n][i] * rs);
                        acc[ai][bj][m][n] = v;
                        part += (v[0] * v[0] + v[1] * v[1]) + (v[2] * v[2] + v[3] * v[3]);
                    }
                part += __shfl_xor(part, 16); part += __shfl_xor(part, 32);
                if (fq == 0) __hip_atomic_store(ssq_out + (size_t)row * 16 + u.pn * 4 + wc, part, __ATOMIC_RELAXED, __HIP_MEMORY_SCOPE_AGENT);
                asm volatile("" : "+v"(acc[ai][0][m][0]), "+v"(acc[ai][0][m][1]), "+v"(acc[ai][1][m][0]), "+v"(acc[ai][1][m][1]));
            }
        asm volatile("s_waitcnt vmcnt(0)" ::: "memory");
        unsigned* c = cnt + 64 * u.pm;
        if (lane == 0) __hip_atomic_fetch_add(c, 1u, __ATOMIC_RELAXED, __HIP_MEMORY_SCOPE_AGENT);
        { unsigned sp = 0;
          while ((unsigned)__builtin_amdgcn_readfirstlane(__hip_atomic_load(c, __ATOMIC_RELAXED, __HIP_MEMORY_SCOPE_AGENT)) < 32u) { __builtin_amdgcn_s_sleep(2); if (++sp > (1u << 22)) break; } }
        __builtin_amdgcn_fence(__ATOMIC_ACQUIRE, "agent");
        f32x4 g[2][2];
#pragma unroll
        for (int bj = 0; bj < 2; ++bj) { g[bj][0] = *(const f32x4*)(gfin + col0 + bj * HALF); g[bj][1] = *(const f32x4*)(gfin + col0 + bj * HALF + 16); }
#pragma unroll
        for (int ai = 0; ai < 2; ++ai)
#pragma unroll
            for (int m = 0; m < 4; ++m) {
                if (m == 0) asm volatile("" ::: "memory");
                const int row = u.pm * BM + wr * 64 + ai * HALF + m * 16 + fr;
                const float rs = rstd_q(ssq_out + (size_t)row * 16, fq);
                const size_t off = (size_t)row * 1024 + col0;
#pragma unroll
                for (int bj = 0; bj < 2; ++bj) { *(f32x4*)(out + off + bj * HALF) = acc[ai][bj][m][0] * rs * g[bj][0]; *(f32x4*)(out + off + bj * HALF + 16) = acc[ai][bj][m][1] * rs * g[bj][1]; }
            }
    }
};


template <class Epi, class Sched, bool ALIGN_EPI = false, bool SP2 = false>
__device__ __forceinline__ void gemm_phase(PG8_LAS unsigned char* lds, const Gemm g, const Sched& S, const Epi& E) {
    int tid = threadIdx.x; asm volatile("" : "+v"(tid)); const int wid = __builtin_amdgcn_readfirstlane(tid >> 6), lane = tid & 63, wr = wid >> 2, wc = wid & 3, fr = lane & 15, fq = lane >> 4;
    const int K = g.K, nt = K / BK;
    unsigned voffA[2], voffB[2];
#pragma unroll
    for (int i = 0; i < 2; ++i) { int R, C; stage_rc(tid * 16 + i * 8192, R, C); const int Rb = Epi::PERM ? ((R & ~31) + perm32(R & 31)) : R;
        voffA[i] = (unsigned)(R * K + C) * 2u; voffB[i] = (unsigned)(Rb * K + C) * 2u; }
    const size_t kstep = (size_t)(BK * 2);
    const size_t hstep = (size_t)HALF * K * 2;
    const size_t tstep = 2 * hstep;
    const unsigned ldsw = (unsigned)wid * 1024u;
    const int aoff = lds_byte(wr * 64 + fr, fq * 8), boff = lds_byte(wc * 32 + fr, fq * 8);
#define PG8_SA(b, h) (((b) * 2 + (h)) * HTB)
#define PG8_SB(b, h) ((4 + (b) * 2 + (h)) * HTB)
#define PG8_STAGE(bufoff, gbase, voff) do { _Pragma("unroll") for (int _i = 0; _i < 2; ++_i) \
        __builtin_amdgcn_global_load_lds((const unsigned*)((const char*)(gbase) + (voff)[_i]), (PG8_LAS unsigned*)(lds + (bufoff) + ldsw + _i * 8192), 16, 0, 0); } while (0)
#define PG8_LDA(dst, b, h) do { _Pragma("unroll") for (int m = 0; m < 4; ++m) _Pragma("unroll") for (int k = 0; k < 2; ++k) dst[m][k] = *(const PG8_LAS bf16x8*)(lds + PG8_SA(b, h) + aoff + m * 2048 + k * 1024); } while (0)
#define PG8_LDB(dst, b, h) do { _Pragma("unroll") for (int n = 0; n < 2; ++n) _Pragma("unroll") for (int k = 0; k < 2; ++k) dst[n][k] = *(const PG8_LAS bf16x8*)(lds + PG8_SB(b, h) + boff + n * 2048 + k * 1024); } while (0)
#define PG8_MMA(ai, bj, At, Bt) do { __builtin_amdgcn_s_setprio(1); _Pragma("unroll") for (int m = 0; m < 4; ++m) _Pragma("unroll") for (int n = 0; n < 2; ++n) _Pragma("unroll") for (int k = 0; k < 2; ++k) \
        acc[ai][bj][m][n] = __builtin_amdgcn_mfma_f32_16x16x32_bf16(Bt[n][k], At[m][k], acc[ai][bj][m][n], 0, 0, 0); __builtin_amdgcn_s_setprio(0); } while (0)
#define PG8_WAIT_V(n) asm volatile("s_waitcnt vmcnt(" #n ")" ::: "memory")
#define PG8_WAIT_L(n) asm volatile("s_waitcnt lgkmcnt(" #n ")" ::: "memory")
#define PG8_BAR __builtin_amdgcn_s_barrier()
#define PG8_SCHED __builtin_amdgcn_sched_barrier(0)
    Unit cur, nxt; int ui = 0;
    if (!S.next(0, cur)) return;
    f32x4 acc[2][2][4][2];
#pragma unroll
    for (int a = 0; a < 2; ++a)
#pragma unroll
        for (int b = 0; b < 2; ++b)
#pragma unroll
            for (int m = 0; m < 4; ++m)
#pragma unroll
                for (int n = 0; n < 2; ++n) acc[a][b][m][n] = (f32x4){0.f, 0.f, 0.f, 0.f};
    bf16x8 At[4][2], B0[2][2], B1[2][2];
    const char* cA = (const char*)g.A + (size_t)cur.pm * tstep; const char* cB = (const char*)g.Bt + (size_t)cur.pn * tstep;
    S.a_ready(cur);
    if constexpr (SP2) {
        PG8_STAGE(PG8_SB(0, 0), cB, voffB); PG8_STAGE(PG8_SB(0, 1), cB + hstep, voffB); PG8_STAGE(PG8_SA(0, 0), cA, voffA); PG8_STAGE(PG8_SA(0, 1), cA + hstep, voffA);
        if (wr == 1) PG8_BAR;
        PG8_WAIT_V(2); PG8_BAR;
        PG8_STAGE(PG8_SB(1, 0), cB + kstep, voffB); PG8_STAGE(PG8_SA(1, 0), cA + kstep, voffA); PG8_STAGE(PG8_SB(1, 1), cB + hstep + kstep, voffB);
        PG8_WAIT_V(6); PG8_BAR;
    } else {
        PG8_STAGE(PG8_SB(0, 0), cB, voffB); PG8_STAGE(PG8_SA(0, 0), cA, voffA); PG8_STAGE(PG8_SB(0, 1), cB + hstep, voffB); PG8_STAGE(PG8_SA(0, 1), cA + hstep, voffA);
        if (wr == 1) PG8_BAR;
        PG8_WAIT_V(4); PG8_BAR;
        PG8_STAGE(PG8_SB(1, 0), cB + kstep, voffB); PG8_STAGE(PG8_SA(1, 0), cA + kstep, voffA); PG8_STAGE(PG8_SB(1, 1), cB + hstep + kstep, voffB);
        PG8_WAIT_V(6); PG8_BAR;
    }
    for (;;) {
        const bool has_next = S.next(ui + 1, nxt);
        const char* nA = has_next ? (const char*)g.A + (size_t)nxt.pm * tstep : cA; const char* nB = has_next ? (const char*)g.Bt + (size_t)nxt.pn * tstep : cB;
        for (int t = 0; t < nt; t += 2) {
            const bool last = (t == nt - 2);
            const char* a1 = cA + (size_t)(t + 1) * kstep;
            const char* a2 = last ? nA : cA + (size_t)(t + 2) * kstep; const char* b2 = last ? nB : cB + (size_t)(t + 2) * kstep;
            const char* a3 = a2 + kstep; const char* b3 = b2 + kstep;
            if (last && has_next) S.a_ready(nxt);
            if constexpr (SP2) {
            PG8_LDB(B0, 0, 0); PG8_LDB(B1, 0, 1); PG8_SCHED; PG8_LDA(At, 0, 0); PG8_STAGE(PG8_SA(1, 1), a1 + hstep, voffA);
            PG8_WAIT_V(8); PG8_WAIT_L(0); PG8_BAR; PG8_MMA(0, 0, At, B0); PG8_MMA(0, 1, At, B1); PG8_BAR; PG8_SCHED;
            PG8_LDA(At, 0, 1); PG8_STAGE(PG8_SB(0, 0), b2, voffB); PG8_STAGE(PG8_SB(0, 1), b2 + hstep, voffB); PG8_STAGE(PG8_SA(0, 0), a2, voffA);
            PG8_WAIT_V(8); PG8_WAIT_L(0); PG8_BAR; PG8_MMA(1, 0, At, B0); PG8_MMA(1, 1, At, B1); PG8_BAR; PG8_SCHED;
            PG8_LDB(B0, 1, 0); PG8_LDB(B1, 1, 1); PG8_SCHED; PG8_LDA(At, 1, 0); PG8_STAGE(PG8_SA(0, 1), a2 + hstep, voffA);
            PG8_WAIT_V(8); PG8_WAIT_L(0); PG8_BAR; PG8_MMA(0, 0, At, B0); PG8_MMA(0, 1, At, B1); PG8_BAR; PG8_SCHED;
            PG8_LDA(At, 1, 1); PG8_STAGE(PG8_SB(1, 0), b3, voffB); PG8_STAGE(PG8_SB(1, 1), b3 + hstep, voffB); PG8_STAGE(PG8_SA(1, 0), a3, voffA);
            PG8_WAIT_V(8); PG8_WAIT_L(0); PG8_BAR; PG8_MMA(1, 0, At, B0); PG8_MMA(1, 1, At, B1); PG8_BAR; PG8_SCHED;
            } else {
            PG8_LDB(B0, 0, 0); PG8_SCHED; PG8_LDA(At, 0, 0); PG8_STAGE(PG8_SA(1, 1), a1 + hstep, voffA);
            PG8_WAIT_L(8); PG8_BAR; PG8_WAIT_L(0); PG8_MMA(0, 0, At, B0); PG8_BAR; PG8_SCHED;
            PG8_LDB(B1, 0, 1); PG8_STAGE(PG8_SB(0, 0), b2, voffB);
            PG8_BAR; PG8_WAIT_L(0); PG8_MMA(0, 1, At, B1); PG8_BAR;
            PG8_LDA(At, 0, 1); PG8_STAGE(PG8_SA(0, 0), a2, voffA);
            PG8_BAR; PG8_WAIT_L(0); PG8_MMA(1, 0, At, B0); PG8_BAR; PG8_SCHED;
            PG8_STAGE(PG8_SB(0, 1), b2 + hstep, voffB);
            PG8_WAIT_V(6); PG8_BAR; PG8_MMA(1, 1, At, B1); PG8_BAR;
            PG8_LDB(B0, 1, 0); PG8_SCHED; PG8_LDA(At, 1, 0); PG8_STAGE(PG8_SA(0, 1), a2 + hstep, voffA);
            PG8_WAIT_L(8); PG8_BAR; PG8_WAIT_L(0); PG8_MMA(0, 0, At, B0); PG8_BAR; PG8_SCHED;
            PG8_LDB(B1, 1, 1); PG8_STAGE(PG8_SB(1, 0), b3, voffB);
            PG8_BAR; PG8_WAIT_L(0); PG8_MMA(0, 1, At, B1); PG8_BAR;
            PG8_LDA(At, 1, 1); PG8_STAGE(PG8_SA(1, 0), a3, voffA);
            PG8_BAR; PG8_WAIT_L(0); PG8_MMA(1, 0, At, B0); PG8_BAR; PG8_SCHED;
            PG8_STAGE(PG8_SB(1, 1), b3 + hstep, voffB);
            PG8_WAIT_V(6); PG8_BAR; PG8_MMA(1, 1, At, B1); PG8_BAR;
            }
        }
        if constexpr (ALIGN_EPI) { if (wr == 0) PG8_BAR; }
        if constexpr (!Epi::AFTER_DRAIN) { E(acc, cur, wr, wc, fr, fq); S.done(cur); }
        if (!has_next) break;
#pragma unroll
        for (int a = 0; a < 2; ++a)
#pragma unroll
            for (int b = 0; b < 2; ++b)
#pragma unroll
                for (int m = 0; m < 4; ++m)
#pragma unroll
                    for (int n = 0; n < 2; ++n) acc[a][b][m][n] = (f32x4){0.f, 0.f, 0.f, 0.f};
        cur = nxt; cA = nA; cB = nB; ++ui;
        if constexpr (ALIGN_EPI) { if (wr == 1) PG8_BAR; }
    }
    PG8_WAIT_V(0);
    if constexpr (!ALIGN_EPI) { if (wr == 0) PG8_BAR; }
    PG8_BAR;
    if constexpr (Epi::AFTER_DRAIN) { E.fused(acc, cur, wr, wc, fr, fq, lds, wid, lane); S.done(cur); }
#undef PG8_SA
#undef PG8_SB
#undef PG8_STAGE
#undef PG8_LDA
#undef PG8_LDB
#undef PG8_MMA
#undef PG8_WAIT_V
#undef PG8_WAIT_L
#undef PG8_BAR
#undef PG8_SCHED
}
}

#ifndef PG8_SP2
#define PG8_SP2 true
#endif
#ifndef PG8_ALIGN
#define PG8_ALIGN true
#endif
#include <hip/hip_bf16.h>
#include <cmath>
namespace attn_body {
using bf16=__hip_bfloat16;
using bf16x8=__attribute__((ext_vector_type(8)))short;
using s16x4=__attribute__((ext_vector_type(4)))short;
using f32x16=__attribute__((ext_vector_type(16)))float;
using u32x4=__attribute__((ext_vector_type(4)))unsigned;
constexpr int BATCH=2,SEQ=8192,D=64;
constexpr int NW=8,QBLK=32,QB=QBLK*NW,KVBLK=64;
__device__ __forceinline__ int crow(int r,int hi){return (r&3)+8*(r>>2)+4*hi;}
#define SBAR() __builtin_amdgcn_sched_barrier(0)
template<int MODE> __device__ __forceinline__ void amask(f32x16&p0,f32x16&p1,int t,int NT,int joff,int qrel,int hi){
  const float NEG=-INFINITY;
  if(MODE==0){ const int jb=t-(NT-4); if(jb<0)return; const int kb=64*jb+4*hi;
    #pragma unroll
    for(int r=0;r<16;++r){int kv=kb+(r&3)+8*(r>>2); if(kv>qrel)p0[r]=NEG; if(kv+32>qrel)p1[r]=NEG;}
  } else { const int kb=64*(t+joff)+4*hi-qrel;
    #pragma unroll
    for(int r=0;r<16;++r){int dv=kb+(r&3)+8*(r>>2); if((unsigned)dv>128u)p0[r]=NEG; if((unsigned)(dv+32)>128u)p1[r]=NEG;}
  }
}

constexpr int NSLOT=3, SLOTB=8192;
constexpr int LDS_K=0, LDS_V=NSLOT*SLOTB, LDS_WS=2*NSLOT*SLOTB, LDS_OST=LDS_WS+NW*64*4, LDS_BYTES=LDS_OST+NW*4096;
constexpr float C2=0.125f*1.4426950408889634f;
__device__ __forceinline__ void glds16(const void*sbase,unsigned voff,unsigned lds_dst){unsigned keep;
  asm volatile("s_mov_b32 %0, m0\n\ts_mov_b32 m0, %3\n\ts_nop 0\n\tglobal_load_lds_dwordx4 %1, %2\n\ts_mov_b32 m0, %0":"=&s"(keep):"v"(voff),"s"(sbase),"s"(lds_dst):"memory");}
__device__ __forceinline__ float max3f(float a,float b,float c){float r;asm("v_max3_f32 %0, %1, %2, %3":"=v"(r):"v"(a),"v"(b),"v"(c));return r;}
__device__ __forceinline__ float max2f(float a,float b){float r;asm("v_max_f32_e32 %0, %1, %2":"=v"(r):"v"(a),"v"(b));return r;}
__device__ __forceinline__ float fadd_s(float a,float b){float r;asm("v_add_f32_e32 %0, %1, %2":"=v"(r):"v"(a),"v"(b));return r;}
__device__ __forceinline__ float fsub_s(float a,float b){float r;asm("v_sub_f32_e32 %0, %1, %2":"=v"(r):"v"(a),"v"(b));return r;}
typedef float f32x2_t __attribute__((ext_vector_type(2))); typedef __bf16 bf16x2_t __attribute__((ext_vector_type(2)));
__device__ __forceinline__ unsigned cvtpk_s(float lo,float hi){f32x2_t v={lo,hi};bf16x2_t b=__builtin_convertvector(v,bf16x2_t);return __builtin_bit_cast(unsigned,b);}
#define WAIT_BAR(N) asm volatile("s_waitcnt vmcnt(" #N ") lgkmcnt(0)\n\ts_barrier":::"memory")

__device__ __forceinline__ void qkt(f32x16&p0,f32x16&p1,const char*Kslot,const bf16x8*qr,const f32x16&negm,int r32,int hi){
  const char*kb=Kslot+hi*1024+r32*16;
  #pragma unroll
  for(int d0=0;d0<4;++d0){
    const bf16x8 b0=*reinterpret_cast<const bf16x8*>(kb+d0*2048);
    const bf16x8 b1=*reinterpret_cast<const bf16x8*>(kb+d0*2048+512);
    if(d0==0){p0=__builtin_amdgcn_mfma_f32_32x32x16_bf16(b0,qr[0],negm,0,0,0);p1=__builtin_amdgcn_mfma_f32_32x32x16_bf16(b1,qr[0],negm,0,0,0);}
    else{p0=__builtin_amdgcn_mfma_f32_32x32x16_bf16(b0,qr[d0],p0,0,0,0);p1=__builtin_amdgcn_mfma_f32_32x32x16_bf16(b1,qr[d0],p1,0,0,0);}}
}
typedef __attribute__((address_space(3))) const char* lds_cptr;
typedef short v4i16_t __attribute__((ext_vector_type(4)));
__device__ __forceinline__ void kload8(bf16x8*kf,lds_cptr kp){
  kf[0]=*(const __attribute__((address_space(3))) bf16x8*)(kp);      kf[1]=*(const __attribute__((address_space(3))) bf16x8*)(kp+512);
  kf[2]=*(const __attribute__((address_space(3))) bf16x8*)(kp+2048); kf[3]=*(const __attribute__((address_space(3))) bf16x8*)(kp+2560);
  kf[4]=*(const __attribute__((address_space(3))) bf16x8*)(kp+4096); kf[5]=*(const __attribute__((address_space(3))) bf16x8*)(kp+4608);
  kf[6]=*(const __attribute__((address_space(3))) bf16x8*)(kp+6144); kf[7]=*(const __attribute__((address_space(3))) bf16x8*)(kp+6656);
}
__device__ __forceinline__ void kload2(bf16x8*kf,lds_cptr kp,int j){ kf[2*j]=*(const __attribute__((address_space(3))) bf16x8*)(kp+j*2048); kf[2*j+1]=*(const __attribute__((address_space(3))) bf16x8*)(kp+j*2048+512); }
__device__ __forceinline__ s16x4 vtr(lds_cptr p){ return __builtin_bit_cast(s16x4,__builtin_amdgcn_ds_read_tr16_b64_v4i16((__attribute__((address_space(3))) v4i16_t*)p)); }
__device__ __forceinline__ float rowmax(const f32x16&p0,const f32x16&p1){
  float a=max3f(p0[0],p0[1],p1[0]),b=max3f(p0[2],p0[3],p1[1]);a=max3f(a,p1[2],p1[3]);
  #pragma unroll
  for(int r=4;r<16;r+=4){a=max3f(a,p0[r],p0[r+1]);b=max3f(b,p0[r+2],p0[r+3]);a=max3f(a,p1[r],p1[r+1]);b=max3f(b,p1[r+2],p1[r+3]);}
  const float m=max2f(a,b);
  auto rr=__builtin_amdgcn_permlane32_swap(__float_as_uint(m),__float_as_uint(m),false,false);
  return max2f(__uint_as_float(rr[0]),__uint_as_float(rr[1]));
}
__device__ __forceinline__ void pv(f32x16*o,int vb,bf16x8 pa0,bf16x8 pa1,bf16x8 pa2,bf16x8 pa3){
  #pragma unroll
  for(int d0=0;d0<2;++d0){s16x4 lo[4],hi[4];
    #pragma unroll
    for(int ks=0;ks<4;++ks){
      asm volatile("ds_read_b64_tr_b16 %0,%1 offset:%c2":"=&v"(lo[ks]):"v"(vb),"i"(d0*4096+ks*1024):"memory");
      asm volatile("ds_read_b64_tr_b16 %0,%1 offset:%c2":"=&v"(hi[ks]):"v"(vb),"i"(d0*4096+ks*1024+512):"memory");}
    asm volatile("s_waitcnt lgkmcnt(0)":::"memory");SBAR();
    #define PK(k) (bf16x8){lo[k][0],lo[k][1],lo[k][2],lo[k][3],hi[k][0],hi[k][1],hi[k][2],hi[k][3]}
    o[d0]=__builtin_amdgcn_mfma_f32_32x32x16_bf16(pa0,PK(0),o[d0],0,0,0);
    o[d0]=__builtin_amdgcn_mfma_f32_32x32x16_bf16(pa1,PK(1),o[d0],0,0,0);
    o[d0]=__builtin_amdgcn_mfma_f32_32x32x16_bf16(pa2,PK(2),o[d0],0,0,0);
    o[d0]=__builtin_amdgcn_mfma_f32_32x32x16_bf16(pa3,PK(3),o[d0],0,0,0);
    #undef PK
  }
}

#ifndef ATTN_STORE16
#define ATTN_STORE16(p,v) (*(u32x4*)(p)=(v))
#endif
template<int MODE,int THRL,int qstride,int kvstride,int ostride,int lsestride> __device__ __forceinline__ void attn_unit(const bf16*Q0,const bf16*__restrict__ K0,const bf16*__restrict__ V0,bf16*O0,float*lsep,const int NT,const int joff,char*shm){
  int tid=threadIdx.x; asm volatile("":"+v"(tid)); const int lane=tid&63,r32=lane&31,hi=lane>>5; const int wid=__builtin_amdgcn_readfirstlane(tid>>6);
  const bf16*Qw=Q0+(wid*QBLK)*qstride;
  const bf16*Kh=K0,*Vh=V0;
  const unsigned lds0=(unsigned)(uintptr_t)shm;
  float*wsf=(float*)(shm+LDS_WS)+wid*64;
  const unsigned kvo=(unsigned)(lane*kvstride+wid*8)*2u;
  const unsigned vvo=(unsigned)((16*(wid&3)+(lane>>2))*kvstride+(wid>>2)*32+(lane&3)*8)*2u;
  const unsigned kdst=lds0+LDS_K+wid*1024, vdst=lds0+LDS_V+wid*1024;
  #define DMA_K(t,slot) glds16(Kh+(t)*KVBLK*kvstride,kvo,(unsigned)__builtin_amdgcn_readfirstlane(kdst+(slot)))
  #define DMA_V(t,slot) glds16(Vh+(t)*KVBLK*kvstride,vvo,(unsigned)__builtin_amdgcn_readfirstlane(vdst+(slot)))
  const int vb0=(int)(lds0+LDS_V)+((lane>>4)&1)*32+(lane&3)*8+(4*hi+((lane&15)>>2))*64;
  const char*Kbase=shm+LDS_K; bf16x8 kf[8];
  const lds_cptr shm3=(lds_cptr)shm; const lds_cptr kp0=shm3+LDS_K+hi*1024+r32*16; const lds_cptr vp0=shm3+LDS_V+((lane>>4)&1)*32+(lane&3)*8+(4*hi+((lane&15)>>2))*64;
  DMA_K(0,0);DMA_V(0,0);DMA_K(1,SLOTB);
  bf16x8 qr[4];
  #pragma unroll
  for(int d0=0;d0<4;++d0)qr[d0]=*reinterpret_cast<const bf16x8*>(&Qw[r32*qstride+d0*16+hi*8]);
  float mhat=0.f,l_reg=0.f;f32x16 o[2];o[0]=f32x16{};o[1]=f32x16{};f32x16 negm=f32x16{};asm volatile("":"+v"(negm));
  const int qrel=wid*QBLK+r32;
  #define CMASK(P0,P1,t) amask<MODE>(P0,P1,(t),NT,joff,qrel,hi)
  bool resc=false;
  #define START(P0,P1) do{ const float rm=rowmax(P0,P1); resc=false; \
    { const float dl=(MODE==1&&rm<-1e30f)?0.f:rm; mhat=fadd_s(mhat,dl); \
      _Pragma("unroll") for(int r=0;r<16;++r){P0[r]=fsub_s(P0[r],dl);P1[r]=fsub_s(P1[r],dl);} \
      _Pragma("unroll") for(int r=0;r<16;++r)negm[r]=-mhat; asm volatile("":"+v"(negm)); } \
    _Pragma("unroll") for(int r=0;r<16;++r)P0[r]=__builtin_amdgcn_exp2f(P0[r]); }while(0)
  #define RESC() do{ if(resc){ asm volatile("s_waitcnt lgkmcnt(0)":::"memory"); \
      _Pragma("unroll") for(int d_=0;d_<2;++d_) _Pragma("unroll") for(int r=0;r<16;++r)o[d_][r]*=wsf[crow(r,hi)]; } }while(0)
  f32x16 pA0,pA1,pB0,pB1;
  int sl_prev=0,sl_cur=0,sl_next=SLOTB;
  #define ROT() do{sl_prev=sl_cur;sl_cur=sl_next;sl_next=(sl_next==(NSLOT-1)*SLOTB)?0:sl_next+SLOTB;}while(0)
  DMA_K(2,2*SLOTB);
  WAIT_BAR(3);
  const int t_lo_=(wid>>1)-joff, t_lo=(MODE==1)?(t_lo_<0?0:t_lo_):0, t_hi=(MODE==1)?(t_lo_+2):(NT-1);
  if(t_lo==0){
    qkt(pA0,pA1,Kbase,qr,negm,r32,hi);asm volatile("s_nop 15\n\ts_nop 7":"+v"(pA0),"+v"(pA1));CMASK(pA0,pA1,0);
    START(pA0,pA1);
    _Pragma("unroll") for(int r=0;r<16;++r)pA1[r]=__builtin_amdgcn_exp2f(pA1[r]);
  }
  WAIT_BAR(0);
  DMA_K(3,0);DMA_V(1,SLOTB);
  ROT();
  if(t_lo<=1&&1<=t_hi)kload8(kf,kp0+sl_cur);
  WAIT_BAR(2);
  s16x4 vlo[8],vhi[8]; u32x4 pw0,pw1,pw2,pw3;
  #define PKW(P,B) cvtpk_s(P[B],P[B+1])
  #define PAF(k) __builtin_bit_cast(bf16x8,pw##k)
  #define VFR(i) (bf16x8){vlo[i][0],vlo[i][1],vlo[i][2],vlo[i][3],vhi[i][0],vhi[i][1],vhi[i][2],vhi[i][3]}
  #define PIN(x) asm volatile("":"+v"(x))
  #define MX3(a,b,c) __builtin_fmaxf(__builtin_fmaxf((a),(b)),(c))
  #define GAPA(MF,A0,A1,A2,A3,W0,W1,PW) do{ MF; sacc+=A0; sacc+=A1; sacc+=A2; sacc+=A3; PIN(sacc); W0; W1; PIN(PW); SBAR(); }while(0)
  #define EX(v) __builtin_amdgcn_exp2f(v)
  #define GAPB(MF,X,B) do{ MF; X[B]=EX(X[B]); X[B+1]=EX(X[B+1]); X[B+2]=EX(X[B+2]); X[B+3]=EX(X[B+3]); PIN(X); SBAR(); }while(0)
  #define VRD(i) do{ vlo[i]=vtr(vp_+(((i)>>2)*4096+((i)&3)*1024)); vhi[i]=vtr(vp_+(((i)>>2)*4096+((i)&3)*1024+512)); }while(0)
  #define KRD(G,j) do{ if(G){ kload2(kf,kp0+sl_next,j); SBAR(); } }while(0)
  #define STEP(C0,C1,P0,P1,t,GK,GV,GL) do{ SBAR(); \
    const lds_cptr vp_=vp0+sl_prev; \
    VRD(0); SBAR(); float sacc=(P0[0]+P0[1]); \
    GAPA(C0=__builtin_amdgcn_mfma_f32_32x32x16_bf16(kf[0],qr[0],negm,0,0,0), P0[2],P0[3],P0[4],P0[5],     pw0[0]=PKW(P0,0), pw0[1]=PKW(P0,2), pw0); \
    VRD(4); SBAR(); GAPA(C1=__builtin_amdgcn_mfma_f32_32x32x16_bf16(kf[1],qr[0],negm,0,0,0), P0[6],P0[7],P0[8],P0[9],     pw0[2]=PKW(P0,4), pw0[3]=PKW(P0,6), pw0); \
    VRD(1); SBAR(); GAPA(C0=__builtin_amdgcn_mfma_f32_32x32x16_bf16(kf[2],qr[1],C0,0,0,0),   P0[10],P0[11],P0[12],P0[13], pw1[0]=PKW(P0,8), pw1[1]=PKW(P0,10), pw1); \
    VRD(5); SBAR(); GAPA(C1=__builtin_amdgcn_mfma_f32_32x32x16_bf16(kf[3],qr[1],C1,0,0,0),   P0[14],P0[15],P1[0],P1[1],   pw1[2]=PKW(P0,12),pw1[3]=PKW(P0,14), pw1); \
    VRD(2); SBAR(); GAPA(C0=__builtin_amdgcn_mfma_f32_32x32x16_bf16(kf[4],qr[2],C0,0,0,0),   P1[2],P1[3],P1[4],P1[5],     pw2[0]=PKW(P1,0), pw2[1]=PKW(P1,2), pw2); \
    VRD(6); SBAR(); GAPA(C1=__builtin_amdgcn_mfma_f32_32x32x16_bf16(kf[5],qr[2],C1,0,0,0),   P1[6],P1[7],P1[8],P1[9],     pw2[2]=PKW(P1,4), pw2[3]=PKW(P1,6), pw2); \
    VRD(3); SBAR(); GAPA(C0=__builtin_amdgcn_mfma_f32_32x32x16_bf16(kf[6],qr[3],C0,0,0,0),   P1[10],P1[11],P1[12],P1[13], pw3[0]=PKW(P1,8), pw3[1]=PKW(P1,10), pw3); \
    VRD(7); SBAR(); GAPA(C1=__builtin_amdgcn_mfma_f32_32x32x16_bf16(kf[7],qr[3],C1,0,0,0),   P1[14],P1[15],0.f,0.f,       pw3[2]=PKW(P1,12),pw3[3]=PKW(P1,14), pw3); \
    l_reg+=sacc; \
    if(GK){DMA_K((t)+3,sl_cur);} if(GV){DMA_V((t)+1,sl_next);} \
    CMASK(C0,C1,t); \
    { float a=MX3(C0[0],C0[1],C1[0]),b=MX3(C0[2],C0[3],C1[1]); a=MX3(a,C1[2],C1[3]); \
      _Pragma("unroll") for(int r=4;r<16;r+=4){a=MX3(a,C0[r],C0[r+1]);b=MX3(b,C0[r+2],C0[r+3]);a=MX3(a,C1[r],C1[r+1]);b=MX3(b,C1[r+2],C1[r+3]);} \
      float rm=__builtin_fmaxf(a,b); { auto rr=__builtin_amdgcn_permlane32_swap(__float_as_uint(rm),__float_as_uint(rm),false,false); rm=__builtin_fmaxf(__uint_as_float(rr[0]),__uint_as_float(rr[1])); } \
      resc=false; \
      if(__builtin_expect(__any(rm>(float)THRL),0)){ const float dl=__builtin_fmaxf(rm,0.f); mhat+=dl; \
        _Pragma("unroll") for(int r=0;r<16;++r){C0[r]-=dl;C1[r]-=dl;} \
        _Pragma("unroll") for(int r=0;r<16;++r)negm[r]=-mhat; asm volatile("":"+v"(negm)); \
        const float f=__builtin_amdgcn_exp2f(-dl); l_reg*=f; if(hi==0)wsf[r32]=f; resc=true; } } \
    SBAR(); \
    GAPB(o[0]=__builtin_amdgcn_mfma_f32_32x32x16_bf16(PAF(0),VFR(0),o[0],0,0,0), C0,0); \
    GAPB(o[1]=__builtin_amdgcn_mfma_f32_32x32x16_bf16(PAF(0),VFR(4),o[1],0,0,0), C0,4); \
    KRD(GL,0); GAPB(o[0]=__builtin_amdgcn_mfma_f32_32x32x16_bf16(PAF(1),VFR(1),o[0],0,0,0), C0,8); \
    KRD(GL,1); GAPB(o[1]=__builtin_amdgcn_mfma_f32_32x32x16_bf16(PAF(1),VFR(5),o[1],0,0,0), C0,12); \
    KRD(GL,2); GAPB(o[0]=__builtin_amdgcn_mfma_f32_32x32x16_bf16(PAF(2),VFR(2),o[0],0,0,0), C1,0); \
    KRD(GL,3); GAPB(o[1]=__builtin_amdgcn_mfma_f32_32x32x16_bf16(PAF(2),VFR(6),o[1],0,0,0), C1,4); \
    GAPB(o[0]=__builtin_amdgcn_mfma_f32_32x32x16_bf16(PAF(3),VFR(3),o[0],0,0,0), C1,8); \
    GAPB(o[1]=__builtin_amdgcn_mfma_f32_32x32x16_bf16(PAF(3),VFR(7),o[1],0,0,0), C1,12); \
    }while(0)
  #define ENDW(tt) do{ if((tt)+3<NT){WAIT_BAR(2);} else if((tt)+2<NT){WAIT_BAR(1);} else {WAIT_BAR(0);} }while(0)
  #define PVONLY(P0,P1,slot) do{ float sacc=P0[0]+P0[1]; _Pragma("unroll") for(int r=2;r<16;++r)sacc+=P0[r]; _Pragma("unroll") for(int r=0;r<16;++r)sacc+=P1[r]; l_reg+=sacc; \
    pw0=(u32x4){PKW(P0,0),PKW(P0,2),PKW(P0,4),PKW(P0,6)};pw1=(u32x4){PKW(P0,8),PKW(P0,10),PKW(P0,12),PKW(P0,14)};pw2=(u32x4){PKW(P1,0),PKW(P1,2),PKW(P1,4),PKW(P1,6)};pw3=(u32x4){PKW(P1,8),PKW(P1,10),PKW(P1,12),PKW(P1,14)}; \
    SBAR(); pv(o,vb0+(slot),PAF(0),PAF(1),PAF(2),PAF(3)); }while(0)
  if constexpr(MODE==0){
  int t=1;
  #undef CMASK
  #define CMASK(P0,P1,t) do{}while(0)
  for(;t+5<NT;t+=2){
    STEP(pB0,pB1,pA0,pA1,t,true,true,true);     WAIT_BAR(2); RESC(); ROT();
    STEP(pA0,pA1,pB0,pB1,t+1,true,true,true);   WAIT_BAR(2); RESC(); ROT();
  }
  #undef CMASK
  #define CMASK(P0,P1,t) amask<MODE>(P0,P1,(t),NT,joff,qrel,hi)
  for(;t+1<NT;t+=2){
    STEP(pB0,pB1,pA0,pA1,t,(t+3<NT),(t+1<NT),(t+1<NT));       ENDW(t);   RESC(); ROT();
    STEP(pA0,pA1,pB0,pB1,t+1,(t+4<NT),(t+2<NT),(t+2<NT));     ENDW(t+1); RESC(); ROT();
  }
  STEP(pB0,pB1,pA0,pA1,NT-1,false,false,false); RESC();
  PVONLY(pB0,pB1,sl_cur);
  } else {
  #define QK8(C0,C1) do{ \
    C0=__builtin_amdgcn_mfma_f32_32x32x16_bf16(kf[0],qr[0],negm,0,0,0);C1=__builtin_amdgcn_mfma_f32_32x32x16_bf16(kf[1],qr[0],negm,0,0,0); \
    C0=__builtin_amdgcn_mfma_f32_32x32x16_bf16(kf[2],qr[1],C0,0,0,0);C1=__builtin_amdgcn_mfma_f32_32x32x16_bf16(kf[3],qr[1],C1,0,0,0); \
    C0=__builtin_amdgcn_mfma_f32_32x32x16_bf16(kf[4],qr[2],C0,0,0,0);C1=__builtin_amdgcn_mfma_f32_32x32x16_bf16(kf[5],qr[2],C1,0,0,0); \
    C0=__builtin_amdgcn_mfma_f32_32x32x16_bf16(kf[6],qr[3],C0,0,0,0);C1=__builtin_amdgcn_mfma_f32_32x32x16_bf16(kf[7],qr[3],C1,0,0,0); \
    asm volatile("s_nop 15\n\ts_nop 7":"+v"(C0),"+v"(C1)); }while(0)
  #define QKONLY(C0,C1,s) do{ QK8(C0,C1); CMASK(C0,C1,s); START(C0,C1); \
    _Pragma("unroll") for(int r=0;r<16;++r)C1[r]=__builtin_amdgcn_exp2f(C1[r]); }while(0)
  #define QKNEXT(C0,C1,s) do{ QK8(C0,C1); CMASK(C0,C1,s); \
    { float rm=rowmax(C0,C1); \
      if(__builtin_expect(__any(rm>(float)THRL),0)){ const float dl=__builtin_fmaxf(rm,0.f); mhat+=dl; \
        _Pragma("unroll") for(int r=0;r<16;++r){C0[r]-=dl;C1[r]-=dl;} \
        _Pragma("unroll") for(int r=0;r<16;++r)negm[r]=-mhat; asm volatile("":"+v"(negm)); \
        const float f=__builtin_amdgcn_exp2f(-dl); l_reg*=f; if(hi==0)wsf[r32]=f; resc=true; } } \
    _Pragma("unroll") for(int r=0;r<16;++r){C0[r]=__builtin_amdgcn_exp2f(C0[r]);C1[r]=__builtin_amdgcn_exp2f(C1[r]);} }while(0)
  for(int s=1;s<NT;++s){
    const bool qk_=(t_lo<=s)&&(s<=t_hi), pv_=(t_lo<=s-1)&&(s-1<=t_hi), kn_=(t_lo<=s+1)&&(s+1<=t_hi); resc=false;
    if(pv_){ PVONLY(pA0,pA1,sl_prev); }
    if(qk_){ if(s==t_lo){ QKONLY(pA0,pA1,s); } else { QKNEXT(pA0,pA1,s); } }
    if(s+3<NT){DMA_K(s+3,sl_cur);} if(s+1<NT){DMA_V(s+1,sl_next);}
    if(kn_){ kload8(kf,kp0+sl_next); }
    ENDW(s); RESC(); ROT();
  }
  if(t_hi==NT-1){ PVONLY(pA0,pA1,sl_prev); }
  #undef QK8
  #undef QKNEXT
  #undef QKONLY
  }
  #undef PVONLY
  #undef PKW
  #undef PAF
  #undef VFR
  #undef PIN
  #undef MX3
  #undef GAPA
  #undef GAPB
  #undef EX
  #undef VRD
  #undef KRD
  #undef STEP
  #undef ENDW
  {auto rr=__builtin_amdgcn_permlane32_swap(__float_as_uint(l_reg),__float_as_uint(l_reg),false,false);l_reg=__uint_as_float(rr[0])+__uint_as_float(rr[1]);}
  if(hi==0){wsf[32+r32]=l_reg; if(lsep)lsep[(wid*QBLK+r32)*lsestride]=mhat+__builtin_amdgcn_logf(l_reg);}asm volatile("s_waitcnt lgkmcnt(0)":::"memory");
  float rli[16];
  #pragma unroll
  for(int r=0;r<16;++r)rli[r]=__builtin_amdgcn_rcpf(wsf[32+crow(r,hi)]);
  bf16*Ow=O0+(wid*QBLK)*ostride;
  { bf16*stg=(bf16*)(shm+LDS_OST)+wid*2048;
    #pragma unroll
    for(int r=0;r<16;++r){const int orow=crow(r,hi);
      #pragma unroll
      for(int d0=0;d0<2;++d0)stg[orow*64+d0*32+r32]=__float2bfloat16(o[d0][r]*rli[r]);}
    asm volatile("s_waitcnt lgkmcnt(0)":::"memory");
    #pragma unroll
    for(int i=0;i<4;++i){const int row=i*8+(lane>>3),ch=lane&7; const u32x4 v=*(const u32x4*)(stg+row*64+ch*8); ATTN_STORE16(Ow+row*ostride+ch*8,v);} }
  asm volatile("s_waitcnt lgkmcnt(0)\n\ts_barrier":::"memory");
  #undef DMA_K
  #undef DMA_V
  #undef CMASK
  #undef START
  #undef RESC
  #undef ROT
}
constexpr int VSLOTB=16384, LDS2_K=0, LDS2_V=NSLOT*SLOTB, LDS2_WS=LDS2_V+NSLOT*VSLOTB, LDS2_OST=LDS2_WS+NW*64*4, LDS2_BYTES=LDS2_OST+NW*4096;
__device__ __forceinline__ f32x2_t pk_sub(f32x2_t a,f32x2_t b){f32x2_t r;asm("v_pk_add_f32 %0, %1, %2 neg_lo:[0,1] neg_hi:[0,1]":"=v"(r):"v"(a),"v"(b));return r;}
__device__ __forceinline__ f32x2_t pk_add(f32x2_t a,f32x2_t b){f32x2_t r;asm("v_pk_add_f32 %0, %1, %2":"=v"(r):"v"(a),"v"(b));return r;}
template<int THRL,int qstride,int kvstride,int ostride> __device__ __forceinline__ void attn_unit128(const bf16*Q0,const bf16*__restrict__ K0,const bf16*__restrict__ V0,bf16*O0,const int NT,char*shm){
  int tid=threadIdx.x; asm volatile("":"+v"(tid)); const int lane=tid&63,r32=lane&31,hi=lane>>5; const int wid=__builtin_amdgcn_readfirstlane(tid>>6);
  const bf16*Qw=Q0+(wid*QBLK)*qstride;
  const bf16*Kh=K0,*Vh=V0;
  const unsigned lds0=(unsigned)(uintptr_t)shm;
  float*wsf=(float*)(shm+LDS2_WS)+wid*64;
  const unsigned kvo=(unsigned)(lane*kvstride+wid*8)*2u;
  const unsigned vvo=(unsigned)((16*(wid&3)+(lane>>2))*kvstride+(wid>>2)*32+(lane&3)*8)*2u;
  const unsigned kdst=lds0+LDS2_K+wid*1024, vdst=lds0+LDS2_V+wid*1024;
  #define DMA_K(t,slot) glds16(Kh+(t)*KVBLK*kvstride,kvo,(unsigned)__builtin_amdgcn_readfirstlane(kdst+(slot)))
  #define DMA_V(t,slot) do{ glds16(Vh+(t)*KVBLK*kvstride,vvo,(unsigned)__builtin_amdgcn_readfirstlane(vdst+2*(slot))); glds16(Vh+(t)*KVBLK*kvstride+64,vvo,(unsigned)__builtin_amdgcn_readfirstlane(vdst+2*(slot)+8192)); }while(0)
  const int vb0=(int)(lds0+LDS2_V)+((lane>>4)&1)*32+(lane&3)*8+(4*hi+((lane&15)>>2))*64;
  bf16x8 kf[8];
  const lds_cptr shm3=(lds_cptr)shm; const lds_cptr kp0=shm3+LDS2_K+hi*1024+r32*16; const lds_cptr vp0=shm3+LDS2_V+((lane>>4)&1)*32+(lane&3)*8+(4*hi+((lane&15)>>2))*64;
  DMA_K(0,0);DMA_V(0,0);DMA_K(1,SLOTB);
  bf16x8 qr[4];
  #pragma unroll
  for(int d0=0;d0<4;++d0)qr[d0]=*reinterpret_cast<const bf16x8*>(&Qw[r32*qstride+d0*16+hi*8]);
  float mhat=0.f,l_reg=0.f;f32x16 o[4];o[0]=f32x16{};o[1]=f32x16{};o[2]=f32x16{};o[3]=f32x16{};
  const int qrel=wid*QBLK+r32;
  #define BFR(x) __uint_as_float(cvtpk_s((x),0.f)<<16)
  const bf16x8 kone=(bf16x8){(short)(hi==0?0x3F80:0),0,0,0,0,0,0,0};
  bf16x8 qm=(bf16x8){0,0,0,0,0,0,0,0};
  #define SETQM() do{ const short mb_=(short)(cvtpk_s(-mhat,0.f)&0xffffu); qm[0]=(hi==0)?mb_:(short)0; }while(0)
  #define CMASK(P0,P1,t) amask<0>(P0,P1,(t),NT,0,qrel,hi)
  bool resc=false;
  #define RESC() do{ if(resc){ asm volatile("s_waitcnt lgkmcnt(0)":::"memory"); \
      _Pragma("unroll") for(int r=0;r<16;++r){ const float f_=wsf[crow(r,hi)]; o[0][r]*=f_; o[1][r]*=f_; o[2][r]*=f_; o[3][r]*=f_; } } }while(0)
  f32x16 pA0,pA1,pB0,pB1;
  int sl_prev=0,sl_cur=0,sl_next=SLOTB;
  #define ROT() do{sl_prev=sl_cur;sl_cur=sl_next;sl_next=(sl_next==(NSLOT-1)*SLOTB)?0:sl_next+SLOTB;}while(0)
  DMA_K(2,2*SLOTB);
  WAIT_BAR(4);
  { kload8(kf,kp0);
    const f32x16 z=f32x16{};
    pA0=__builtin_amdgcn_mfma_f32_32x32x16_bf16(kf[0],qr[0],z,0,0,0);pA1=__builtin_amdgcn_mfma_f32_32x32x16_bf16(kf[1],qr[0],z,0,0,0);
    pA0=__builtin_amdgcn_mfma_f32_32x32x16_bf16(kf[2],qr[1],pA0,0,0,0);pA1=__builtin_amdgcn_mfma_f32_32x32x16_bf16(kf[3],qr[1],pA1,0,0,0);
    pA0=__builtin_amdgcn_mfma_f32_32x32x16_bf16(kf[4],qr[2],pA0,0,0,0);pA1=__builtin_amdgcn_mfma_f32_32x32x16_bf16(kf[5],qr[2],pA1,0,0,0);
    pA0=__builtin_amdgcn_mfma_f32_32x32x16_bf16(kf[6],qr[3],pA0,0,0,0);pA1=__builtin_amdgcn_mfma_f32_32x32x16_bf16(kf[7],qr[3],pA1,0,0,0); }
  asm volatile("s_nop 15\n\ts_nop 7":"+v"(pA0),"+v"(pA1));CMASK(pA0,pA1,0);
  { const float rm=rowmax(pA0,pA1); mhat=BFR(rm);
    _Pragma("unroll") for(int r=0;r<16;++r){pA0[r]=__builtin_amdgcn_exp2f(pA0[r]-mhat);pA1[r]=__builtin_amdgcn_exp2f(pA1[r]-mhat);} SETQM(); }
  WAIT_BAR(0);
  DMA_K(3,0);DMA_V(1,SLOTB);
  ROT();
  kload8(kf,kp0+sl_cur);
  WAIT_BAR(3);
  s16x4 vlo[8],vhi[8]; u32x4 pw0,pw1,pw2,pw3;
  #define PKW(P,B) cvtpk_s(P[B],P[B+1])
  #define PAF(k) __builtin_bit_cast(bf16x8,pw##k)
  #define VFR(i) (bf16x8){vlo[i][0],vlo[i][1],vlo[i][2],vlo[i][3],vhi[i][0],vhi[i][1],vhi[i][2],vhi[i][3]}
  #define PIN(x) asm volatile("":"+v"(x))
  #define MX3(a,b,c) __builtin_fmaxf(__builtin_fmaxf((a),(b)),(c))
  #define GAPA(MF,A0,A1,A2,A3,W0,W1,PW) do{ MF; sacc+=A0; sacc+=A1; sacc+=A2; sacc+=A3; PIN(sacc); W0; W1; PIN(PW); SBAR(); }while(0)
  #define EX(v) __builtin_amdgcn_exp2f(v)
  #define GAPB(MF,X,B) do{ MF; X[B]=EX(X[B]); X[B+1]=EX(X[B+1]); PIN(X); SBAR(); }while(0)
  #define VRD(i) do{ vlo[i]=vtr(vp_+(((i)>>2)*4096+((i)&3)*1024)); vhi[i]=vtr(vp_+(((i)>>2)*4096+((i)&3)*1024+512)); }while(0)
  #define VRD2(i) do{ vlo[i]=vtr(vp_+(8192+((i)>>2)*4096+((i)&3)*1024)); vhi[i]=vtr(vp_+(8192+((i)>>2)*4096+((i)&3)*1024+512)); SBAR(); }while(0)
  #define KRD(G,j) do{ if(G){ kload2(kf,kp0+sl_next,j); SBAR(); } }while(0)
  #define ZC (f32x16{})
  #define STEP(C0,C1,P0,P1,t,GK,GV,GL) do{ SBAR(); \
    const lds_cptr vp_=vp0+2*sl_prev; \
    C0=__builtin_amdgcn_mfma_f32_32x32x16_bf16(kone,qm,ZC,0,0,0); C1=__builtin_amdgcn_mfma_f32_32x32x16_bf16(kone,qm,ZC,0,0,0); SBAR(); \
    VRD(0); SBAR(); float sacc=(P0[0]+P0[1]); \
    GAPA(C0=__builtin_amdgcn_mfma_f32_32x32x16_bf16(kf[0],qr[0],C0,0,0,0), P0[2],P0[3],P0[4],P0[5],     pw0[0]=PKW(P0,0), pw0[1]=PKW(P0,2), pw0); \
    VRD(4); SBAR(); GAPA(C1=__builtin_amdgcn_mfma_f32_32x32x16_bf16(kf[1],qr[0],C1,0,0,0), P0[6],P0[7],P0[8],P0[9],     pw0[2]=PKW(P0,4), pw0[3]=PKW(P0,6), pw0); \
    VRD(1); SBAR(); GAPA(C0=__builtin_amdgcn_mfma_f32_32x32x16_bf16(kf[2],qr[1],C0,0,0,0),   P0[10],P0[11],P0[12],P0[13], pw1[0]=PKW(P0,8), pw1[1]=PKW(P0,10), pw1); \
    VRD(5); SBAR(); GAPA(C1=__builtin_amdgcn_mfma_f32_32x32x16_bf16(kf[3],qr[1],C1,0,0,0),   P0[14],P0[15],P1[0],P1[1],   pw1[2]=PKW(P0,12),pw1[3]=PKW(P0,14), pw1); \
    VRD(2); SBAR(); GAPA(C0=__builtin_amdgcn_mfma_f32_32x32x16_bf16(kf[4],qr[2],C0,0,0,0),   P1[2],P1[3],P1[4],P1[5],     pw2[0]=PKW(P1,0), pw2[1]=PKW(P1,2), pw2); \
    VRD(6); SBAR(); GAPA(C1=__builtin_amdgcn_mfma_f32_32x32x16_bf16(kf[5],qr[2],C1,0,0,0),   P1[6],P1[7],P1[8],P1[9],     pw2[2]=PKW(P1,4), pw2[3]=PKW(P1,6), pw2); \
    VRD(3); SBAR(); GAPA(C0=__builtin_amdgcn_mfma_f32_32x32x16_bf16(kf[6],qr[3],C0,0,0,0),   P1[10],P1[11],P1[12],P1[13], pw3[0]=PKW(P1,8), pw3[1]=PKW(P1,10), pw3); \
    VRD(7); SBAR(); GAPA(C1=__builtin_amdgcn_mfma_f32_32x32x16_bf16(kf[7],qr[3],C1,0,0,0),   P1[14],P1[15],0.f,0.f,       pw3[2]=PKW(P1,12),pw3[3]=PKW(P1,14), pw3); \
    l_reg+=sacc; \
    if(GK){DMA_K((t)+3,sl_cur);} if(GV){DMA_V((t)+1,sl_next);} \
    CMASK(C0,C1,t); \
    { float a=MX3(C0[0],C0[1],C1[0]),b=MX3(C0[2],C0[3],C1[1]); a=MX3(a,C1[2],C1[3]); \
      _Pragma("unroll") for(int r=4;r<16;r+=4){a=MX3(a,C0[r],C0[r+1]);b=MX3(b,C0[r+2],C0[r+3]);a=MX3(a,C1[r],C1[r+1]);b=MX3(b,C1[r+2],C1[r+3]);} \
      float rm=__builtin_fmaxf(a,b); { auto rr=__builtin_amdgcn_permlane32_swap(__float_as_uint(rm),__float_as_uint(rm),false,false); rm=__builtin_fmaxf(__uint_as_float(rr[0]),__uint_as_float(rr[1])); } \
      resc=false; \
      if(__builtin_expect(__any(rm>(float)THRL),0)){ const float mn_=BFR(mhat+__builtin_fmaxf(rm,0.f)); const float dl=mn_-mhat; mhat=mn_; SETQM(); \
        _Pragma("unroll") for(int r=0;r<16;++r){C0[r]-=dl;C1[r]-=dl;} \
        const float f=__builtin_amdgcn_exp2f(-dl); l_reg*=f; if(hi==0)wsf[r32]=f; resc=true; } } \
    SBAR(); \
    GAPB(o[0]=__builtin_amdgcn_mfma_f32_32x32x16_bf16(PAF(0),VFR(0),o[0],0,0,0), C0,0);  VRD2(0); \
    GAPB(o[1]=__builtin_amdgcn_mfma_f32_32x32x16_bf16(PAF(0),VFR(4),o[1],0,0,0), C0,2);  VRD2(4); \
    GAPB(o[0]=__builtin_amdgcn_mfma_f32_32x32x16_bf16(PAF(1),VFR(1),o[0],0,0,0), C0,4);  VRD2(1); \
    GAPB(o[1]=__builtin_amdgcn_mfma_f32_32x32x16_bf16(PAF(1),VFR(5),o[1],0,0,0), C0,6);  VRD2(5); \
    GAPB(o[0]=__builtin_amdgcn_mfma_f32_32x32x16_bf16(PAF(2),VFR(2),o[0],0,0,0), C0,8);  VRD2(2); \
    GAPB(o[1]=__builtin_amdgcn_mfma_f32_32x32x16_bf16(PAF(2),VFR(6),o[1],0,0,0), C0,10); VRD2(6); \
    GAPB(o[0]=__builtin_amdgcn_mfma_f32_32x32x16_bf16(PAF(3),VFR(3),o[0],0,0,0), C0,12); VRD2(3); \
    GAPB(o[1]=__builtin_amdgcn_mfma_f32_32x32x16_bf16(PAF(3),VFR(7),o[1],0,0,0), C0,14); VRD2(7); \
    GAPB(o[2]=__builtin_amdgcn_mfma_f32_32x32x16_bf16(PAF(0),VFR(0),o[2],0,0,0), C1,0); \
    GAPB(o[3]=__builtin_amdgcn_mfma_f32_32x32x16_bf16(PAF(0),VFR(4),o[3],0,0,0), C1,2); \
    KRD(GL,0); GAPB(o[2]=__builtin_amdgcn_mfma_f32_32x32x16_bf16(PAF(1),VFR(1),o[2],0,0,0), C1,4); \
    KRD(GL,1); GAPB(o[3]=__builtin_amdgcn_mfma_f32_32x32x16_bf16(PAF(1),VFR(5),o[3],0,0,0), C1,6); \
    KRD(GL,2); GAPB(o[2]=__builtin_amdgcn_mfma_f32_32x32x16_bf16(PAF(2),VFR(2),o[2],0,0,0), C1,8); \
    KRD(GL,3); GAPB(o[3]=__builtin_amdgcn_mfma_f32_32x32x16_bf16(PAF(2),VFR(6),o[3],0,0,0), C1,10); \
    GAPB(o[2]=__builtin_amdgcn_mfma_f32_32x32x16_bf16(PAF(3),VFR(3),o[2],0,0,0), C1,12); \
    GAPB(o[3]=__builtin_amdgcn_mfma_f32_32x32x16_bf16(PAF(3),VFR(7),o[3],0,0,0), C1,14); \
    }while(0)
  int t=1;
  #undef CMASK
  #define CMASK(P0,P1,t) do{}while(0)
  for(;t+5<NT;t+=2){
    STEP(pB0,pB1,pA0,pA1,t,true,true,true);     WAIT_BAR(3); RESC(); ROT();
    STEP(pA0,pA1,pB0,pB1,t+1,true,true,true);   WAIT_BAR(3); RESC(); ROT();
  }
  #undef CMASK
  #define CMASK(P0,P1,t) amask<0>(P0,P1,(t),NT,0,qrel,hi)
  #define ENDW(tt) do{ if((tt)+3<NT){WAIT_BAR(3);} else if((tt)+2<NT){WAIT_BAR(2);} else {WAIT_BAR(0);} }while(0)
  for(;t+1<NT;t+=2){
    STEP(pB0,pB1,pA0,pA1,t,(t+3<NT),(t+1<NT),(t+1<NT));       ENDW(t);   RESC(); ROT();
    STEP(pA0,pA1,pB0,pB1,t+1,(t+4<NT),(t+2<NT),(t+2<NT));     ENDW(t+1); RESC(); ROT();
  }
  STEP(pB0,pB1,pA0,pA1,NT-1,false,false,false); RESC();
  { float sacc=pB0[0]+pB0[1]; _Pragma("unroll") for(int r=2;r<16;++r)sacc+=pB0[r]; _Pragma("unroll") for(int r=0;r<16;++r)sacc+=pB1[r]; l_reg+=sacc;
    pw0=(u32x4){PKW(pB0,0),PKW(pB0,2),PKW(pB0,4),PKW(pB0,6)};pw1=(u32x4){PKW(pB0,8),PKW(pB0,10),PKW(pB0,12),PKW(pB0,14)};pw2=(u32x4){PKW(pB1,0),PKW(pB1,2),PKW(pB1,4),PKW(pB1,6)};pw3=(u32x4){PKW(pB1,8),PKW(pB1,10),PKW(pB1,12),PKW(pB1,14)};
    SBAR(); pv(o,vb0+2*sl_cur,PAF(0),PAF(1),PAF(2),PAF(3)); SBAR(); pv(o+2,vb0+2*sl_cur+8192,PAF(0),PAF(1),PAF(2),PAF(3)); }
  #undef PKW
  #undef PAF
  #undef VFR
  #undef PIN
  #undef MX3
  #undef GAPA
  #undef GAPB
  #undef EX
  #undef VRD
  #undef VRD2
  #undef KRD
  #undef ZC
  #undef BFR
  #undef SETQM
  #undef STEP
  #undef ENDW
  {auto rr=__builtin_amdgcn_permlane32_swap(__float_as_uint(l_reg),__float_as_uint(l_reg),false,false);l_reg=__uint_as_float(rr[0])+__uint_as_float(rr[1]);}
  if(hi==0){wsf[32+r32]=l_reg;}asm volatile("s_waitcnt lgkmcnt(0)":::"memory");
  float rli[16];
  #pragma unroll
  for(int r=0;r<16;++r)rli[r]=__builtin_amdgcn_rcpf(wsf[32+crow(r,hi)]);
  bf16*Ow=O0+(wid*QBLK)*ostride;
  { bf16*stg=(bf16*)(shm+LDS2_OST)+wid*2048;
    #pragma unroll
    for(int j=0;j<2;++j){
      #pragma unroll
      for(int r=0;r<16;++r){const int orow=crow(r,hi);
        #pragma unroll
        for(int d0=0;d0<2;++d0)stg[orow*64+d0*32+r32]=__float2bfloat16(o[2*j+d0][r]*rli[r]);}
      asm volatile("s_waitcnt lgkmcnt(0)":::"memory");
      #pragma unroll
      for(int i=0;i<4;++i){const int row=i*8+(lane>>3),ch=lane&7; const u32x4 v=*(const u32x4*)(stg+row*64+ch*8); ATTN_STORE16(Ow+row*ostride+j*64+ch*8,v);}
      asm volatile("s_waitcnt lgkmcnt(0)":::"memory"); } }
  asm volatile("s_waitcnt lgkmcnt(0)\n\ts_barrier":::"memory");
  #undef DMA_K
  #undef DMA_V
  #undef CMASK
  #undef RESC
  #undef ROT
}
constexpr int DS_K=0, DS_V=6*8192, DS_WS=12*8192, DS_OST=DS_WS+NW*64*4, DS_BYTES=DS_OST+NW*4096;
struct DswaUnit { const bf16* Q0; const bf16* K0; const bf16* V0; bf16* O0; float* ls; int d; int kmin; int chain; };
__device__ __forceinline__ DswaUnit dswa_desc(int u,const bf16*U,bf16*OA,float*LSE){
  constexpr int UPc=3072, SEQc=8192, Mc=16384;
  const int g=u>>9, rem=u&511, b=rem>>8, h=(rem>>5)&7, w=rem&31;
  const int d=g==0?1:(g==1?4:16), nqb=32/d, r=w/nqb, qb=w%nqb, l0=256*qb;
  const long rb=(long)b*SEQc, pos0=(long)l0*d+r, kpos0=(long)(l0-128)*d+r;
  DswaUnit x; x.Q0=U+(rb+pos0)*UPc+h*64; x.K0=U+(rb+kpos0)*UPc+512+h*64; x.V0=U+(rb+kpos0)*UPc+1024+h*64;
  x.O0=OA+(long)g*Mc*512+(rb+pos0)*512+h*64; x.ls=LSE+(long)g*Mc*8+(rb+pos0)*8+h; x.d=d; x.kmin=qb==0?128:0; x.chain=(rem<511&&qb+1<nqb)?1:0; return x;
}
__device__ __forceinline__ void wait_vm(int n){
  switch(n){ case 0: asm volatile("s_waitcnt vmcnt(0)":::"memory"); break; case 2: asm volatile("s_waitcnt vmcnt(2)":::"memory"); break; case 4: asm volatile("s_waitcnt vmcnt(4)":::"memory"); break;
    case 6: asm volatile("s_waitcnt vmcnt(6)":::"memory"); break; case 8: asm volatile("s_waitcnt vmcnt(8)":::"memory"); break; default: asm volatile("s_waitcnt vmcnt(10)":::"memory"); break; }
}
template<int THRL> __device__ __forceinline__ void dswa_phase(const bf16*U,bf16*OA,float*LSE,const int ubase,const int nunits,char*shm){
  constexpr int UPc=3072;
  int tid=threadIdx.x; asm volatile("":"+v"(tid)); const int lane=tid&63,r32=lane&31,hi=lane>>5; const int wid=__builtin_amdgcn_readfirstlane(tid>>6);
  const unsigned lds0=(unsigned)(uintptr_t)shm;
  float*wsf=(float*)(shm+DS_WS)+wid*64;
  const unsigned kvo1=(unsigned)(lane*UPc)*2u, vvo1=(unsigned)((16*(wid&3)+(lane>>2))*UPc)*2u, kvoc=(unsigned)(wid*8)*2u, vvoc=(unsigned)((wid>>2)*32+(lane&3)*8)*2u;
  const unsigned kdst=lds0+DS_K+wid*1024, vdst=lds0+DS_V+wid*1024;
  const lds_cptr shm3=(lds_cptr)shm; const lds_cptr kp0=shm3+DS_K+hi*1024+r32*16;
  const int vb0=(int)(lds0+DS_V)+((lane>>4)&1)*32+(lane&3)*8+(4*hi+((lane&15)>>2))*64;
  const int qrel=wid*QBLK+r32;
  #define DS_ISSUE(X,t,sl) do{ const int ks_=64*(t)*UPc*(X).d; \
    glds16((X).K0+ks_,kvo1*(unsigned)(X).d+kvoc,(unsigned)__builtin_amdgcn_readfirstlane(kdst+(sl)*8192)); \
    glds16((X).V0+ks_,vvo1*(unsigned)(X).d+vvoc,(unsigned)__builtin_amdgcn_readfirstlane(vdst+(sl)*8192)); }while(0)
  #define SLOT(map,t) (((map)>>(4*(t)))&7)
  #define DS_LOADQ(X) do{ const bf16*Qw_=(X).Q0+(wid*QBLK+r32)*(UPc*(X).d); _Pragma("unroll") for(int d0=0;d0<4;++d0)qr[d0]=*reinterpret_cast<const bf16x8*>(Qw_+d0*16+hi*8); }while(0)
  #define PKW(P,B) cvtpk_s(P[B],P[B+1])
  #define PAF(k) __builtin_bit_cast(bf16x8,pw##k)
  DswaUnit cur=dswa_desc(ubase,U,OA,LSE);
  bf16x8 qr[4]; bf16x8 kf[8]; u32x4 pw0,pw1,pw2,pw3; f32x16 p0,p1;
  #pragma unroll
  for(int t=0;t<6;++t)DS_ISSUE(cur,t,t);
  unsigned smap=0x543210u;
  DS_LOADQ(cur);
  for(int ui=0;ui<nunits;++ui){
    const bool has_next=ui+1<nunits;
    DswaUnit nxt=cur; if(has_next)nxt=dswa_desc(ubase+ui+1,U,OA,LSE);
    const bool chain=has_next&&cur.chain!=0; const int nt0=chain?2:0;
    const unsigned nmap=chain?(((smap>>16)&0xffu)|((smap&0xffffu)<<8)):smap;
    const int t_a=wid>>1, t_min=cur.kmin>>6, t_lo=t_a<t_min?t_min:t_a;
    const int mlo=cur.kmin-qrel, lo_=mlo<0?0:mlo;
    float mhat=0.f,l_reg=0.f; f32x16 o[2]; o[0]=f32x16{}; o[1]=f32x16{}; f32x16 negm=f32x16{}; asm volatile("":"+v"(negm));
    #pragma unroll
    for(int j=0;j<3;++j){
      const int s=t_a+j;
      wait_vm(j==0?4:((j==1||has_next)?2:0));
      asm volatile("s_waitcnt lgkmcnt(0)\n\ts_barrier":::"memory");
      if(has_next&&j>0)DS_ISSUE(nxt,nt0+j-1,SLOT(smap,j-1));
      if(s>=t_lo){
        kload8(kf,kp0+SLOT(smap,s)*8192);
        p0=__builtin_amdgcn_mfma_f32_32x32x16_bf16(kf[0],qr[0],negm,0,0,0);p1=__builtin_amdgcn_mfma_f32_32x32x16_bf16(kf[1],qr[0],negm,0,0,0);
        p0=__builtin_amdgcn_mfma_f32_32x32x16_bf16(kf[2],qr[1],p0,0,0,0);p1=__builtin_amdgcn_mfma_f32_32x32x16_bf16(kf[3],qr[1],p1,0,0,0);
        p0=__builtin_amdgcn_mfma_f32_32x32x16_bf16(kf[4],qr[2],p0,0,0,0);p1=__builtin_amdgcn_mfma_f32_32x32x16_bf16(kf[5],qr[2],p1,0,0,0);
        p0=__builtin_amdgcn_mfma_f32_32x32x16_bf16(kf[6],qr[3],p0,0,0,0);p1=__builtin_amdgcn_mfma_f32_32x32x16_bf16(kf[7],qr[3],p1,0,0,0);
        asm volatile("s_nop 15\n\ts_nop 7":"+v"(p0),"+v"(p1));
        if(j!=1||cur.kmin!=0){ const int kb=64*s+4*hi-qrel-lo_; const unsigned span=(unsigned)(128-lo_);
          #pragma unroll
          for(int r=0;r<16;++r){ const int dv=kb+(r&3)+8*(r>>2); if((unsigned)dv>span)p0[r]=-INFINITY; if((unsigned)(dv+32)>span)p1[r]=-INFINITY; } }
        const float rm=rowmax(p0,p1); bool resc=false;
        if(s==t_lo){ const float dl=(rm<-1e30f)?0.f:rm; mhat+=dl;
          #pragma unroll
          for(int r=0;r<16;++r){p0[r]-=dl;p1[r]-=dl;}
          #pragma unroll
          for(int r=0;r<16;++r)negm[r]=-mhat;
          asm volatile("":"+v"(negm)); }
        else if(__any(rm>(float)THRL)){ const float dl=__builtin_fmaxf(rm,0.f); mhat+=dl;
          #pragma unroll
          for(int r=0;r<16;++r){p0[r]-=dl;p1[r]-=dl;}
          #pragma unroll
          for(int r=0;r<16;++r)negm[r]=-mhat;
          asm volatile("":"+v"(negm));
          const float f=__builtin_amdgcn_exp2f(-dl); l_reg*=f; if(hi==0)wsf[r32]=f; resc=true; }
        #pragma unroll
        for(int r=0;r<16;++r){p0[r]=__builtin_amdgcn_exp2f(p0[r]);p1[r]=__builtin_amdgcn_exp2f(p1[r]);}
        if(resc){ asm volatile("s_waitcnt lgkmcnt(0)":::"memory");
          #pragma unroll
          for(int r=0;r<16;++r){ const float f_=wsf[crow(r,hi)]; o[0][r]*=f_; o[1][r]*=f_; } }
        { float sacc=p0[0]+p0[1];
          #pragma unroll
          for(int r=2;r<16;++r)sacc+=p0[r];
          #pragma unroll
          for(int r=0;r<16;++r)sacc+=p1[r];
          l_reg+=sacc; }
        pw0=(u32x4){PKW(p0,0),PKW(p0,2),PKW(p0,4),PKW(p0,6)};pw1=(u32x4){PKW(p0,8),PKW(p0,10),PKW(p0,12),PKW(p0,14)};pw2=(u32x4){PKW(p1,0),PKW(p1,2),PKW(p1,4),PKW(p1,6)};pw3=(u32x4){PKW(p1,8),PKW(p1,10),PKW(p1,12),PKW(p1,14)};
        pv(o,vb0+SLOT(smap,s)*8192,PAF(0),PAF(1),PAF(2),PAF(3));
      }
    }
    const DswaUnit fin=cur;
    asm volatile("s_waitcnt lgkmcnt(0)\n\ts_barrier":::"memory");
    if(has_next)DS_LOADQ(nxt);
    {auto rr=__builtin_amdgcn_permlane32_swap(__float_as_uint(l_reg),__float_as_uint(l_reg),false,false);l_reg=__uint_as_float(rr[0])+__uint_as_float(rr[1]);}
    if(hi==0){wsf[32+r32]=l_reg; fin.ls[(wid*QBLK+r32)*(8*fin.d)]=mhat+__builtin_amdgcn_logf(l_reg);}asm volatile("s_waitcnt lgkmcnt(0)":::"memory");
    float rli[16];
    #pragma unroll
    for(int r=0;r<16;++r)rli[r]=__builtin_amdgcn_rcpf(wsf[32+crow(r,hi)]);
    { bf16*Ow=fin.O0+(wid*QBLK)*(512*fin.d); bf16*stg=(bf16*)(shm+DS_OST)+wid*2048;
      #pragma unroll
      for(int r=0;r<16;++r){const int orow=crow(r,hi);
        #pragma unroll
        for(int d0=0;d0<2;++d0)stg[orow*64+d0*32+r32]=__float2bfloat16(o[d0][r]*rli[r]);}
      asm volatile("s_waitcnt lgkmcnt(0)":::"memory");
      #pragma unroll
      for(int i=0;i<4;++i){const int row=i*8+(lane>>3),ch=lane&7; const u32x4 v=*(const u32x4*)(stg+row*64+ch*8); *(u32x4*)(Ow+row*(512*fin.d)+ch*8)=v;} }
    asm volatile("":::"memory");
    if(has_next){ if(chain){ DS_ISSUE(nxt,4,SLOT(smap,2)); DS_ISSUE(nxt,5,SLOT(smap,3)); } else { DS_ISSUE(nxt,2,SLOT(smap,2)); DS_ISSUE(nxt,3,SLOT(smap,3)); DS_ISSUE(nxt,4,SLOT(smap,4)); DS_ISSUE(nxt,5,SLOT(smap,5)); } }
    cur=nxt; smap=nmap;
  }
  asm volatile("s_waitcnt vmcnt(0)":::"memory");
  #undef DS_ISSUE
  #undef SLOT
  #undef DS_LOADQ
  #undef PKW
  #undef PAF
}
constexpr int ATTN_LDS_BYTES=LDS2_BYTES;
#undef SBAR
#undef WAIT_BAR
}
namespace cg = cooperative_groups;
constexpr int NWAVES = 8;
#ifndef MK_N_LAUNCHES
#define MK_N_LAUNCHES 1
#endif
constexpr int NPHASE = 11;
constexpr int SEQ = 8192, DM = 1024, M = 16384, INC = 4096, PLE = 256, UP = 3072;
constexpr size_t MiB = 1u << 20;
constexpr size_t WS_ROPE = 1 * MiB, WS_SSQA = WS_ROPE + 512 * 1024, WS_LSE = WS_SSQA + 1 * MiB;
constexpr size_t WS_WIN = 4 * MiB, WS_WOUT = 20 * MiB, WS_WGATE = 24 * MiB, WS_WPLE = 28 * MiB, WS_SSQB = 29 * MiB;
constexpr size_t WS_PB = 30 * MiB, WS_HB2 = 46 * MiB, WS_GATE = 78 * MiB, WS_OA = 110 * MiB, WS_U = 158 * MiB, WS_END = 254 * MiB;
constexpr size_t WS_OD = WS_HB2, WS_E = WS_U, WS_HB1 = WS_U + 32 * MiB;
static_assert(WS_LSE + 3 * (size_t)M * 8 * 4 <= WS_WIN && WS_U + (size_t)M * UP * 2 == WS_END, "d_ws map");
constexpr int LDS_BYTES = 155648;
#ifndef REP_PRO
#define REP_PRO 1
#endif
#ifndef REP_G1
#define REP_G1 1
#endif
#ifndef REP_DIFF
#define REP_DIFF 1
#endif
#ifndef REP_DSWA
#define REP_DSWA 1
#endif
#ifndef REP_G2
#define REP_G2 1
#endif
#ifndef REP_G3D
#define REP_G3D 0
#endif
#ifndef REP_E
#define REP_E 1
#endif

#define GAS __attribute__((address_space(1)))
#define LAS __attribute__((address_space(3)))
typedef unsigned short bf16;
typedef unsigned v4u __attribute__((ext_vector_type(4)));
typedef float f32x4 __attribute__((ext_vector_type(4)));
#define LDS_WAIT() asm volatile("s_waitcnt lgkmcnt(0)" ::: "memory")
__device__ __forceinline__ unsigned f2bf(float f) { unsigned u = __builtin_bit_cast(unsigned, f); return (u + 0x7fffu + ((u >> 16) & 1u)) >> 16; }
__device__ __forceinline__ unsigned pk2(float lo, float hi) { return f2bf(lo) | (f2bf(hi) << 16); }
__device__ __forceinline__ float bflo(unsigned u) { return __uint_as_float(u << 16); }
__device__ __forceinline__ float bfhi(unsigned u) { return __uint_as_float(u & 0xffff0000u); }
__device__ __forceinline__ float wave_sum(float v) {
#pragma unroll
    for (int o = 1; o < 64; o <<= 1) v += __shfl_xor(v, o);
    return v;
}
typedef GAS unsigned gu32;
#define RLX_AGENT __ATOMIC_RELAXED, __HIP_MEMORY_SCOPE_AGENT
constexpr int RSL_OFF = 133120, ROPEL_OFF = RSL_OFF + 1024, MISC_OFF = ROPEL_OFF + 16384;
constexpr size_t WS_CTL = 0, CTL_ZERO_BYTES = 65536;
#define XB_TMO      128
#define XB_XCNT(j)  (256  + 64 * (j))
#define XB_XSUB(j)  (1280 + 64 * (j))
#define XB_XGEN(j)  (2304 + 64 * (j))
#define XB_TOP      3328
#define XB_TOPGEN   3392
#define XCD_BAR_WORDS 3456
#define XB_SPIN_CAP (1u << 18)

__device__ __forceinline__ unsigned xb_ld(unsigned* p)              { return __hip_atomic_load(p, __ATOMIC_RELAXED, __HIP_MEMORY_SCOPE_AGENT); }
__device__ __forceinline__ unsigned xb_add(unsigned* p, unsigned v) { return __hip_atomic_fetch_add(p, v, __ATOMIC_RELAXED, __HIP_MEMORY_SCOPE_AGENT); }
__device__ __forceinline__ unsigned xb_xcc_id() { return (unsigned)__builtin_amdgcn_s_getreg((3 << 11) | 20) & 0xFu; }
#define XB_SPIN(cond, bar) do { unsigned _sp = 0; while (cond) { __builtin_amdgcn_s_sleep(1); \
    if ((++_sp & 255u) == 0u) { if (xb_ld(&(bar)[XB_TMO])) break; if (_sp > XB_SPIN_CAP) { atomicAdd(&(bar)[XB_TMO], 1u); break; } } } } while (0)

struct XcdBarrier {
    unsigned* bar; unsigned x;
    volatile LAS unsigned* st;
};

__device__ __forceinline__ XcdBarrier xcd_barrier_post(unsigned* bar, volatile LAS unsigned* st) {
    XcdBarrier b; b.bar = bar; b.x = xb_xcc_id(); b.st = st;
    if (threadIdx.x == 0) (void)xb_add(&bar[XB_XCNT(b.x)], 1u);
    return b;
}
__device__ __forceinline__ void xcd_barrier_complete(unsigned* bar, unsigned x, unsigned& nloc, unsigned& nx) {
    const unsigned G = gridDim.x * gridDim.y * gridDim.z;
    unsigned sum, cnt, mine, sp = 0u;
    for (;;) {
        sum = 0u; cnt = 0u; mine = 0u;
#pragma unroll
        for (unsigned j = 0; j < 16; ++j) { const unsigned c = xb_ld(&bar[XB_XCNT(j)]); sum += c; cnt += (c > 0u) ? 1u : 0u; mine = (j == x) ? c : mine; }
        if (sum == G) break;
        __builtin_amdgcn_s_sleep(1);
        if ((++sp & 255u) == 0u) { if (xb_ld(&bar[XB_TMO])) break; if (sp > XB_SPIN_CAP) { atomicAdd(&bar[XB_TMO], 1u); break; } }
    }
    nloc = mine > 0u ? mine : 1u; nx = cnt > 0u ? cnt : 1u;
}

__device__ __forceinline__ void xcd_barrier(const XcdBarrier& b) {
    asm volatile("s_waitcnt vmcnt(0)" ::: "memory");
    __syncthreads();
    if (threadIdx.x == 0) {
        unsigned* bar = b.bar;
        __builtin_amdgcn_s_waitcnt(0);
        unsigned nloc = b.st[0], nx = b.st[1];
        if (nloc == 0u) { xcd_barrier_complete(bar, b.x, nloc, nx); b.st[0] = nloc; b.st[1] = nx; }
        const unsigned old = xb_add(&bar[XB_XSUB(b.x)], 1u);
        const unsigned gen = old / nloc;
        if (old + 1u == (gen + 1u) * nloc) {
            __builtin_amdgcn_fence(__ATOMIC_RELEASE, "agent");
            asm volatile("s_waitcnt vmcnt(0)" ::: "memory");
            const unsigned og = xb_add(&bar[XB_TOP], 1u);
            const unsigned tg = og / nx;
            if (og + 1u == (tg + 1u) * nx) xb_add(&bar[XB_TOPGEN], 1u);
            else XB_SPIN(xb_ld(&bar[XB_TOPGEN]) == tg, bar);
            __builtin_amdgcn_fence(__ATOMIC_ACQUIRE, "agent");
            xb_add(&bar[XB_XGEN(b.x)], 1u);
            asm volatile("s_waitcnt vmcnt(0)" ::: "memory");
        } else {
            XB_SPIN(xb_ld(&bar[XB_XGEN(b.x)]) == gen, bar);
            __builtin_amdgcn_fence(__ATOMIC_ACQUIRE, "agent");
            asm volatile("s_waitcnt vmcnt(0)" ::: "memory");
        }
    }
    __syncthreads();
}

__device__ __forceinline__ void p0_transpose_item(const float* W, const float* gain, int K, int N, bf16* WT, LAS float* scr, int item, int lane) {
    const int nblk = N / 64, kb = item / nblk, nb = item % nblk, k0 = 32 * kb, n0 = 64 * nb;
    f32x4 v[8];
#pragma unroll
    for (int i = 0; i < 8; ++i) { const int kk = 4 * i + (lane >> 4); v[i] = *(const f32x4*)(W + (size_t)(k0 + kk) * N + n0 + (lane & 15) * 4); }
#pragma unroll
    for (int i = 0; i < 8; ++i) { const int kk = 4 * i + (lane >> 4); const float g = gain ? gain[k0 + kk] : 1.0f; LAS float* d = scr + kk * 65 + (lane & 15) * 4;
        d[0] = g * v[i][0]; d[1] = g * v[i][1]; d[2] = g * v[i][2]; d[3] = g * v[i][3]; }
    LDS_WAIT(); asm volatile("" ::: "memory");
    const int c = lane & 3;
#pragma unroll
    for (int j = 0; j < 4; ++j) { const int n = (lane >> 2) + 16 * j; const LAS float* s = scr + (8 * c) * 65 + n;
        v4u o; o.x = pk2(s[0 * 65], s[1 * 65]); o.y = pk2(s[2 * 65], s[3 * 65]); o.z = pk2(s[4 * 65], s[5 * 65]); o.w = pk2(s[6 * 65], s[7 * 65]);
        *(GAS v4u*)(WT + (size_t)(n0 + n) * K + k0 + 8 * c) = o; }
    LDS_WAIT(); asm volatile("" ::: "memory");
}

struct BalancedOrder : pg8::StaticOrder {
    __device__ bool next(int i, pg8::Unit& u) const { const bool r = pg8::StaticOrder::next(i, u); if (r && u.pn >= 4 && u.pn < 12) u.pn ^= 2; return r; }
};
struct Args { const float* in[14]; float* out; unsigned char* ws; int ph_lo, ph_hi; };
static_assert(sizeof(Args) == 14 * 8 + 8 + 8 + 8, "Args has no padding");

__global__ void __launch_bounds__(NWAVES * 64, 2) hymba_fwd(Args args) {
    extern __shared__ __attribute__((aligned(16))) unsigned char lds[];
    typedef const __attribute__((address_space(4))) Args* kargp_t;
    kargp_t KA = (kargp_t)__builtin_amdgcn_kernarg_segment_ptr();
#define PTRS() asm volatile("" : "+s"(KA)); unsigned char* ws = KA->ws; \
    int tid = threadIdx.x; asm volatile("" : "+v"(tid)); const int lane = tid & 63, wave = __builtin_amdgcn_readfirstlane(tid >> 6); \
    const int G = gridDim.x; const int bx = blockIdx.x; const int vcu = (G % 8 == 0) ? (bx % 8) * (G / 8) + bx / 8 : bx; const int gw = vcu * NWAVES + wave, NGW = G * NWAVES; (void)lane; (void)gw; (void)NGW; \
    const float* x = KA->in[0]; const float* p = KA->in[1]; const float* attn_g = KA->in[2]; const float* w_in = KA->in[3]; const float* w_out = KA->in[4]; \
    const float* lq1 = KA->in[5]; const float* lk1 = KA->in[6]; const float* lq2 = KA->in[7]; const float* lk2 = KA->in[8]; const float* subln_g = KA->in[9]; \
    const float* ple_g = KA->in[10]; const float* w_gate = KA->in[11]; const float* w_ple = KA->in[12]; const float* final_g = KA->in[13]; \
    float* H = KA->out; \
    float* ROPE = (float*)(ws + WS_ROPE); float* SSQA = (float*)(ws + WS_SSQA); float* SSQB = (float*)(ws + WS_SSQB); float* LSE = (float*)(ws + WS_LSE); \
    bf16* WIN = (bf16*)(ws + WS_WIN); bf16* WOUT = (bf16*)(ws + WS_WOUT); bf16* WGATE = (bf16*)(ws + WS_WGATE); bf16* WPLE = (bf16*)(ws + WS_WPLE); \
    bf16* PB = (bf16*)(ws + WS_PB); bf16* HB2 = (bf16*)(ws + WS_HB2); bf16* HB1 = (bf16*)(ws + WS_HB1); bf16* GATE = (bf16*)(ws + WS_GATE); \
    bf16* OA = (bf16*)(ws + WS_OA); bf16* OD = (bf16*)H;     bf16* U = (bf16*)(ws + WS_U); bf16* EB = (bf16*)(ws + WS_E); \
    (void)x; (void)p; (void)attn_g; (void)w_in; (void)w_out; (void)lq1; (void)lk1; (void)lq2; (void)lk2; (void)subln_g; (void)ple_g; (void)w_gate; (void)w_ple; (void)final_g; (void)H; \
    (void)ROPE; (void)SSQA; (void)SSQB; (void)LSE; (void)WIN; (void)WOUT; (void)WGATE; (void)WPLE; (void)PB; (void)HB2; (void)HB1; (void)GATE; (void)OA; (void)OD; (void)U; (void)EB
    const int lo = KA->ph_lo, hi = KA->ph_hi;
    { volatile LAS unsigned* M0 = (volatile LAS unsigned*)((LAS unsigned char*)lds + MISC_OFF); if (threadIdx.x < 32) M0[threadIdx.x] = 0u; }
    __syncthreads();
    XcdBarrier bar = xcd_barrier_post((unsigned*)(KA->ws + WS_CTL) + 1024, (volatile LAS unsigned*)((LAS unsigned char*)lds + MISC_OFF) + 8);
#define IN(k) (lo <= (k) && (k) < hi)
#define SEAM(k) do { if (IN(k) && IN((k) + 1)) xcd_barrier(bar); } while (0)

    if (IN(0)) for (int rep = 0; rep < REP_PRO; ++rep) { PTRS();
        LAS float* scr = (LAS float*)((LAS unsigned char*)lds + wave * 16384);
        constexpr int I_IN = (DM / 32) * (INC / 64), I_SQ = (DM / 32) * (DM / 64), I_PL = (PLE / 32) * (DM / 64), I_L = I_IN + 2 * I_SQ + I_PL;
        for (int it = gw; it < 2 * I_L; it += NGW) {
            const int l = it / I_L; int r = it % I_L;
            if (r < I_IN) { p0_transpose_item(w_in + (size_t)l * DM * INC, attn_g + l * DM, DM, INC, WIN + (size_t)l * DM * INC, scr, r, lane); continue; } r -= I_IN;
            if (r < I_SQ) { p0_transpose_item(w_out + (size_t)l * DM * DM, nullptr, DM, DM, WOUT + (size_t)l * DM * DM, scr, r, lane); continue; } r -= I_SQ;
            if (r < I_SQ) { p0_transpose_item(w_gate + (size_t)l * DM * DM, ple_g + l * DM, DM, DM, WGATE + (size_t)l * DM * DM, scr, r, lane); continue; } r -= I_SQ;
            p0_transpose_item(w_ple + (size_t)l * PLE * DM, nullptr, PLE, DM, WPLE + (size_t)l * PLE * DM, scr, r, lane);
        }
        for (int m0 = gw; m0 < M; m0 += 4 * NGW) {
            f32x4 v[4][4];
#pragma unroll
            for (int q = 0; q < 4; ++q) { const int m = m0 + q * NGW; const f32x4* xr = (const f32x4*)(x + (size_t)(m < M ? m : m0) * DM) + lane;
#pragma unroll
                for (int j = 0; j < 4; ++j) v[q][j] = xr[64 * j]; }
#pragma unroll
            for (int q = 0; q < 4; ++q) { const int m = m0 + q * NGW; if (m < M) {
                unsigned long long* o8 = (unsigned long long*)(HB2 + (size_t)m * DM) + lane; float s = 0.f;
#pragma unroll
                for (int j = 0; j < 4; ++j) { const f32x4 w = v[q][j]; s += (w[0] * w[0] + w[1] * w[1]) + (w[2] * w[2] + w[3] * w[3]); o8[64 * j] = (unsigned long long)pk2(w[0], w[1]) | ((unsigned long long)pk2(w[2], w[3]) << 32); }
                s = wave_sum(s);
                if (lane < 16) SSQA[(size_t)m * 16 + lane] = lane == 0 ? s : 0.f; } }
        }
        { const size_t NI = (size_t)2 * M * PLE / 8, ST = (size_t)NGW * 64;
          for (size_t i0 = (size_t)gw * 64 + lane; i0 < NI; i0 += 4 * ST) {
            f32x4 a[4], b[4];
#pragma unroll
            for (int q = 0; q < 4; ++q) { const size_t i = i0 + q * ST < NI ? i0 + q * ST : i0; a[q] = ((const f32x4*)p)[2 * i]; b[q] = ((const f32x4*)p)[2 * i + 1]; }
#pragma unroll
            for (int q = 0; q < 4; ++q) { const size_t i = i0 + q * ST; if (i < NI) { v4u o; o.x = pk2(a[q][0], a[q][1]); o.y = pk2(a[q][2], a[q][3]); o.z = pk2(b[q][0], b[q][1]); o.w = pk2(b[q][2], b[q][3]); ((v4u*)PB)[i] = o; } }
          } }
        for (int i = gw * 64 + lane; i < SEQ * 8; i += NGW * 64) {
            const int pos = i >> 3, c = i & 7;
            const float inv = c == 0 ? 1.0f : c == 1 ? 0.19392274474868576f : c == 2 ? 0.03760603093086393f : c == 3 ? 0.007292664737217109f : c == 4 ? 0.001414213562373095f : c == 5 ? 0.0002742481756762073f : c == 6 ? 5.318295896944988e-05f : 1.031338537721246e-05f;
            const float ang = (float)pos * inv;
            const double rev = (double)ang * 0.15915494309189535; const float fr = (float)(rev - __builtin_rint(rev));
            ROPE[pos * 16 + c] = __builtin_amdgcn_cosf(fr); ROPE[pos * 16 + 8 + c] = __builtin_amdgcn_sinf(fr);
        }
    }
    SEAM(0);

auto layer = [&](auto LC) __attribute__((always_inline)) {
        constexpr int l = decltype(LC)::value;
        constexpr int P = 1 + 5 * l;
        if (IN(P)) for (int rep = 0; rep < REP_G1; ++rep) { PTRS();
            pg8::Gemm g{HB2, WIN + (size_t)l * DM * INC, M, INC, DM}; BalancedOrder S; S.init(M, INC, G, bx);
            LAS float* rsl = (LAS float*)((LAS unsigned char*)lds + RSL_OFF);
            { pg8::Unit u0; S.next(0, u0); pg8::Unit u3; const bool same = !S.next(3, u3) || u3.pm == u0.pm; (void)same;
              if (tid < 256) rsl[tid] = pg8::rstd_of(SSQA + (size_t)(u0.pm * 256 + tid) * 16);
              { const int rr = tid & 255, hf = tid >> 8; const f32x4* src = (const f32x4*)(ROPE + (size_t)((u0.pm * 256 + rr) & 8191) * 16 + hf * 8); LAS f32x4* dst = (LAS f32x4*)((LAS unsigned char*)lds + ROPEL_OFF) + rr * 4 + hf * 2; dst[0] = src[0]; dst[1] = src[1]; }
              __syncthreads(); }
            pg8::EpiQKVG E{U, GATE, rsl, (LAS float*)((LAS unsigned char*)lds + ROPEL_OFF)};
            pg8::gemm_phase<pg8::EpiQKVG, BalancedOrder, PG8_ALIGN, PG8_SP2>((LAS unsigned char*)lds, g, S, E);
        }
        SEAM(P);
        if (IN(P + 1)) { PTRS();
            using abf = attn_body::bf16;
            for (int rep = 0; rep < REP_DIFF; ++rep) { const int bhc = vcu >> 4, s = vcu & 15, c = bhc & 1, h = (bhc >> 1) & 3, b = bhc >> 3;
              for (int i = 0; i < 2; ++i) { const int qb = (i == 0) ? s : 31 - s; const size_t rb = (size_t)b * SEQ, q0 = (size_t)qb * 256;
                  const abf* Q0 = (const abf*)U + (rb + q0) * UP + 1536 + h * 128 + c * 64; const abf* K0 = (const abf*)U + rb * UP + 2048 + h * 128 + c * 64; const abf* V0 = (const abf*)U + rb * UP + 2560 + h * 128;
                  abf* O0 = (abf*)OD + (size_t)c * M * 512 + (rb + q0) * 512 + h * 128;
                  attn_body::attn_unit128<8, UP, UP, 512>(Q0, K0, V0, O0, 4 * (qb + 1), (char*)lds); } }
            for (int rep = 0; rep < REP_DSWA; ++rep) attn_body::dswa_phase<8>((const abf*)U, (abf*)OA, LSE, vcu * 6, 6, (char*)lds);
        }
        SEAM(P + 1);
        if (IN(P + 2)) { PTRS();
            const float linit = l == 0 ? 0.2f : 0.35550906759096934f;
            const float s1 = wave_sum(lq1[l * 64 + lane] * lk1[l * 64 + lane]), s2 = wave_sum(lq2[l * 64 + lane] * lk2[l * 64 + lane]);
            const float lam = __expf(s1) - __expf(s2) + linit;
            const f32x4 sg0 = *(const f32x4*)(subln_g + l * 128 + (lane & 15) * 8), sg1 = *(const f32x4*)(subln_g + l * 128 + (lane & 15) * 8 + 4);
            for (int m = gw; m < M; m += NGW) {
                const int ha = lane >> 3;
                const float L0 = LSE[(size_t)m * 8 + ha], L1 = LSE[(size_t)M * 8 + (size_t)m * 8 + ha], L2 = LSE[(size_t)2 * M * 8 + (size_t)m * 8 + ha];
                const float Lm = fmaxf(L0, fmaxf(L1, L2)); float w0 = __builtin_amdgcn_exp2f(L0 - Lm), w1 = __builtin_amdgcn_exp2f(L1 - Lm), w2 = __builtin_amdgcn_exp2f(L2 - Lm);
                const float wi = __builtin_amdgcn_rcpf(w0 + w1 + w2); w0 *= wi; w1 *= wi; w2 *= wi;
                const v4u a0 = *(const v4u*)(OA + (size_t)m * 512 + lane * 8), a1 = *(const v4u*)(OA + (size_t)M * 512 + (size_t)m * 512 + lane * 8), a2 = *(const v4u*)(OA + (size_t)2 * M * 512 + (size_t)m * 512 + lane * 8);
                v4u* gp = (v4u*)(GATE + (size_t)m * DM + lane * 8); const v4u ga = *gp; v4u o;
#pragma unroll
                for (int j = 0; j < 4; ++j) { const float vl = (w0 * bflo(a0[j]) + w1 * bflo(a1[j]) + w2 * bflo(a2[j])) * bflo(ga[j]), vhh = (w0 * bfhi(a0[j]) + w1 * bfhi(a1[j]) + w2 * bfhi(a2[j])) * bfhi(ga[j]); o[j] = pk2(vl, vhh); }
                *gp = o;
                const v4u d0 = *(const v4u*)(OD + (size_t)m * 512 + lane * 8), d1 = *(const v4u*)(OD + (size_t)M * 512 + (size_t)m * 512 + lane * 8);
                v4u* gq = (v4u*)(GATE + (size_t)m * DM + 512 + lane * 8); const v4u gb = *gq;
                float dv[8]; float ss = 0.f;
#pragma unroll
                for (int j = 0; j < 4; ++j) { dv[2 * j] = bflo(d0[j]) - lam * bflo(d1[j]); dv[2 * j + 1] = bfhi(d0[j]) - lam * bfhi(d1[j]); ss += dv[2 * j] * dv[2 * j] + dv[2 * j + 1] * dv[2 * j + 1]; }
                ss += __shfl_xor(ss, 1); ss += __shfl_xor(ss, 2); ss += __shfl_xor(ss, 4); ss += __shfl_xor(ss, 8);
                const float rs = __builtin_amdgcn_rsqf(ss * (1.0f / 128.0f) + 1e-5f) * (1.0f - linit);
#pragma unroll
                for (int j = 0; j < 4; ++j) { const float g0 = j < 2 ? sg0[2 * j] : sg1[2 * j - 4], g1 = j < 2 ? sg0[2 * j + 1] : sg1[2 * j - 3]; o[j] = pk2(dv[2 * j] * rs * g0 * bflo(gb[j]), dv[2 * j + 1] * rs * g1 * bfhi(gb[j])); }
                *gq = o;
            }
        }
        SEAM(P + 2);
        if (IN(P + 3)) { PTRS();
            for (int rep = 0; rep < (l == 0 ? REP_G2 : 1); ++rep) { pg8::Gemm g{GATE, WOUT + (size_t)l * DM * DM, M, DM, DM}; pg8::StaticOrder S; S.init(M, DM, G, bx);
              pg8::EpiRes<l == 0> E{x, HB2, HB1, SSQB};
              pg8::gemm_phase<pg8::EpiRes<l == 0>, pg8::StaticOrder, PG8_ALIGN, PG8_SP2>((LAS unsigned char*)lds, g, S, E); }
            for (int rep = 0; rep < REP_E; ++rep) { pg8::Gemm g{PB + (size_t)l * M * PLE, WPLE + (size_t)l * PLE * DM, M, DM, PLE}; pg8::StaticOrder S; S.init(M, DM, G, bx);
              pg8::EpiE E{EB};
              pg8::gemm_phase<pg8::EpiE, pg8::StaticOrder, PG8_ALIGN, PG8_SP2>((LAS unsigned char*)lds, g, S, E); }
        }
        SEAM(P + 3);
        if (IN(P + 4)) { PTRS();
            pg8::Gemm g{HB1, WGATE + (size_t)l * DM * DM, M, DM, DM}; pg8::StaticOrder S; S.init(M, DM, G, bx);
            for (int rep = 0; rep < REP_G3D; ++rep) { pg8::EpiE E{OA}; pg8::gemm_phase<pg8::EpiE, pg8::StaticOrder, PG8_ALIGN, PG8_SP2>((LAS unsigned char*)lds, g, S, E); }
            if constexpr (l == 0) { pg8::EpiPle E{HB1, EB, HB2, SSQB, SSQA};
                pg8::gemm_phase<pg8::EpiPle, pg8::StaticOrder, PG8_ALIGN, PG8_SP2>((LAS unsigned char*)lds, g, S, E); }
            else {
                pg8::EpiPleFinal E{HB1, EB, SSQB, SSQA, (unsigned*)(ws + WS_CTL) + 8192, final_g, H};
                pg8::gemm_phase<pg8::EpiPleFinal, pg8::StaticOrder, false, PG8_SP2>((LAS unsigned char*)lds, g, S, E); }
        }
        if constexpr (l == 0) SEAM(P + 4);
    };
    layer(std::integral_constant<int, 0>{});
    layer(std::integral_constant<int, 1>{});
#undef IN
#undef SEAM
}

extern "C" void kernel_launch(void* const* d_in, const int* in_sizes, int n_in, void* d_out, int out_size, void* d_ws, size_t ws_size, hipStream_t stream) {
    static int grid = 0;
    if (grid == 0) {
        if (n_in != 14 || out_size != M * DM || ws_size < WS_END) { fprintf(stderr, "kernel_launch: unexpected shapes (n_in %d out %d ws %zu)\n", n_in, out_size, ws_size); grid = -1; return; }
        int dev = 0, cus = 0, per_cu = 0;
        hipGetDevice(&dev); hipDeviceGetAttribute(&cus, hipDeviceAttributeMultiprocessorCount, dev);
        if (hipFuncSetAttribute((const void*)hymba_fwd, hipFuncAttributeMaxDynamicSharedMemorySize, LDS_BYTES) != hipSuccess) { fprintf(stderr, "kernel_launch: hipFuncSetAttribute failed\n"); grid = -1; return; }
        if (hipOccupancyMaxActiveBlocksPerMultiprocessor(&per_cu, (const void*)hymba_fwd, NWAVES * 64, LDS_BYTES) != hipSuccess || per_cu < 1) { fprintf(stderr, "kernel_launch: occupancy query says %d\n", per_cu); per_cu = 1; }
        (void)hipGetLastError();
        grid = cus * (per_cu > 1 ? 1 : per_cu);
        fprintf(stderr, "kernel_launch: grid %d (cus %d, per_cu %d)\n", grid, cus, per_cu);
    }
    if (grid < 0) return;
    if (hipMemsetAsync((char*)d_ws + WS_CTL, 0, CTL_ZERO_BYTES, stream) != hipSuccess) { fprintf(stderr, "kernel_launch: memset failed\n"); return; }
    Args a{};
    for (int i = 0; i < 14; ++i) a.in[i] = (const float*)d_in[i];
    a.out = (float*)d_out; a.ws = (unsigned char*)d_ws;
    for (int li = 0; li < MK_N_LAUNCHES; ++li) {
        a.ph_lo = (MK_N_LAUNCHES == 1) ? 0 : li; a.ph_hi = (MK_N_LAUNCHES == 1) ? NPHASE : li + 1;
        void* kargs[] = {&a};
        const hipError_t le = hipLaunchCooperativeKernel((const void*)hymba_fwd, dim3(grid), dim3(NWAVES * 64), kargs, LDS_BYTES, stream);
        if (le != hipSuccess) { fprintf(stderr, "kernel_launch: launch %d failed: %s\n", li, hipGetErrorName(le)); break; }
    }
}
```

```cpp
#include <hip/hip_runtime.h>
#include <hip/hip_cooperative_groups.h>
#include <cstdio>
#include <cstdint>
#include <type_traits>
namespace pg8 {
#define PG8_LAS __attribute__((address_space(3)))
typedef unsigned short bf16_t;
typedef short bf16x8 __attribute__((ext_vector_type(8)));
typedef float f32x4 __attribute__((ext_vector_type(4)));
typedef unsigned u32x4 __attribute__((ext_vector_type(4)));
constexpr int BM = 256, BK = 64, HALF = 128, HTB = HALF * BK * 2  , STAGE_BYTES = 8 * HTB, NXCD = 8, WGM = 8;

__host__ __device__ __forceinline__ int lds_byte(int r, int c) { const int st = (r >> 4) * 2 + (c >> 5), rr = r & 15, cc = c & 31, ob = rr * 64 + cc * 2; return st * 1024 + (ob ^ (((ob >> 9) & 1) << 5)); }
__host__ __device__ __forceinline__ void stage_rc(int b, int& R, int& C) { const int st = b / 1024, sb = b % 1024, swz = sb ^ (((sb >> 9) & 1) << 5); R = (st >> 1) * 16 + swz / 64; C = (st & 1) * 32 + (swz % 64) / 2; }
__host__ __device__ __forceinline__ int perm32(int rho) { const int n = rho >> 4, i = rho & 15; return 8 * (i >> 2) + 4 * n + (i & 3); }

struct Unit { int pm, pn; };
struct Gemm { const bf16_t* A; const bf16_t* Bt; int M, N, K; };

struct StaticOrder {
    int nM, nN, nwg, G, c;
    __host__ __device__ void init(int M, int N, int G_, int c_) { nM = M / BM; nN = N / BM; nwg = nM * nN; G = G_; c = c_; }
    __host__ __device__ bool next(int i, Unit& u) const {
        const long L = (long)i * G + c; if (L >= nwg) return false;
        int wgid = (int)L; { const int q = nwg / NXCD, r = nwg % NXCD, xcd = wgid % NXCD, off = wgid / NXCD; wgid = (xcd < r ? xcd * (q + 1) : r * (q + 1) + (xcd - r) * q) + off; }
        const int nig = WGM * nN, gid = wgid / nig, fm = gid * WGM, gsz = (nM - fm) < WGM ? (nM - fm) : WGM;
        u.pm = fm + ((wgid % nig) % gsz); u.pn = (wgid % nig) / gsz; return true;
    }
    __device__ __forceinline__ void a_ready(const Unit&) const {}
    __device__ __forceinline__ void done(const Unit&) const {}
};

__device__ __forceinline__ unsigned cvt_pk_bf16(float lo, float hi) { unsigned r; asm volatile("v_cvt_pk_bf16_f32 %0, %1, %2" : "=v"(r) : "v"(lo), "v"(hi)); return r; }
typedef float f32x2 __attribute__((ext_vector_type(2)));
__device__ __forceinline__ f32x2 gelu_pk(f32x2 v) {
    const f32x2 av = __builtin_elementwise_abs(v), d = av * 0.2316418882f + 1.0f;
    f32x2 t; t.x = __builtin_amdgcn_rcpf(d.x); t.y = __builtin_amdgcn_rcpf(d.y);
    f32x2 q = t * 0.5307027145f + (-0.7265760135f); q = q * t + 0.7107068705f; q = q * t + (-0.142248368f); q = q * t + 0.127414796f; q = q * t;
    const f32x2 s = (v * v) * (-0.72134752044f);
    f32x2 e; e.x = __builtin_amdgcn_exp2f(s.x); e.y = __builtin_amdgcn_exp2f(s.y);
    const f32x2 m = v * (q * e), r = v - m;
    f32x2 o; o.x = v.x < 0.f ? m.x : r.x; o.y = v.y < 0.f ? m.y : r.y; return o;
}

template <int ACT  > struct EpiBf16 {
    static constexpr bool PERM = true, AFTER_DRAIN = false; static_assert(ACT == 0 || ACT == 1, "EpiBf16: ACT is 0 (none) or 1 (gelu_pk)");
    bf16_t* O; int ldc; const float* bias; int split_cols; size_t split_stride; float scale0;
    __device__ __forceinline__ void operator()(const f32x4 (&acc)[2][2][4][2], const Unit& u, int wr, int wc, int fr, int fq) const {
        const int row0 = u.pm * BM + wr * 64 + fr; int colt = u.pn * BM; bf16_t* base = O;
        float sc = 1.f; if (split_cols) { const int t = colt / split_cols; base += (size_t)t * split_stride; colt -= t * split_cols; if (t == 0) sc = scale0; }
        const int col0 = colt + wc * 32 + 8 * fq, bcol0 = u.pn * BM + wc * 32 + 8 * fq;
        f32x4 bv[2][2];
#pragma unroll
        for (int bj = 0; bj < 2; ++bj)
#pragma unroll
            for (int n = 0; n < 2; ++n) bv[bj][n] = bias ? *(const f32x4*)(bias + bcol0 + bj * HALF + 4 * n) : (f32x4){0.f, 0.f, 0.f, 0.f};
#pragma unroll
        for (int ai = 0; ai < 2; ++ai)
#pragma unroll
            for (int m = 0; m < 4; ++m) { bf16_t* rowp = base + (size_t)(row0 + ai * HALF + m * 16) * ldc + col0;
#pragma unroll
                for (int bj = 0; bj < 2; ++bj) { f32x4 v0 = acc[ai][bj][m][0] + bv[bj][0], v1 = acc[ai][bj][m][1] + bv[bj][1];
                    if (ACT == 1) { f32x2 a = gelu_pk((f32x2){v0[0], v0[1]}), b = gelu_pk((f32x2){v0[2], v0[3]}), c = gelu_pk((f32x2){v1[0], v1[1]}), d = gelu_pk((f32x2){v1[2], v1[3]});
                        v0 = (f32x4){a.x, a.y, b.x, b.y}; v1 = (f32x4){c.x, c.y, d.x, d.y}; }
                    v0 = v0 * sc; v1 = v1 * sc; u32x4 w; w.x = cvt_pk_bf16(v0[0], v0[1]); w.y = cvt_pk_bf16(v0[2], v0[3]); w.z = cvt_pk_bf16(v1[0], v1[1]); w.w = cvt_pk_bf16(v1[2], v1[3]);
                    *(u32x4*)(rowp + bj * HALF) = w; } }
    }
};

__device__ __forceinline__ float ssq16(const float* p) { const f32x4 a = ((const f32x4*)p)[0], b = ((const f32x4*)p)[1], c = ((const f32x4*)p)[2], d = ((const f32x4*)p)[3];
    return (((a[0] + a[1]) + (a[2] + a[3])) + ((b[0] + b[1]) + (b[2] + b[3]))) + (((c[0] + c[1]) + (c[2] + c[3])) + ((d[0] + d[1]) + (d[2] + d[3]))); }
__device__ __forceinline__ float rstd_of(const float* p) { return __builtin_amdgcn_rsqf(ssq16(p) * (1.0f / 1024.0f) + 1e-6f); }
__device__ __forceinline__ float sigm(float x) { return __builtin_amdgcn_rcpf(1.0f + __builtin_amdgcn_exp2f(-1.4426950408889634f * x)); }
constexpr float QSCALE = 0.125f * 1.4426950408889634f;
struct EpiQKVG {
    static constexpr bool PERM = true, AFTER_DRAIN = false;
    bf16_t* U; bf16_t* GATE; const PG8_LAS float* rsl; const PG8_LAS float* rope;
    __device__ __forceinline__ void operator()(const f32x4 (&acc)[2][2][4][2], const Unit& u, int wr, int wc, int fr, int fq) const {
        const int type = u.pn >> 1, t3 = type & 3;
        const bool isg = t3 == 3, isq = t3 == 0;
        bf16_t* base; int ld, colt;
        if (isg) { base = GATE; ld = 1024; colt = (type >> 2) * 512 + (u.pn & 1) * 256; }
        else { base = U; ld = 3072; colt = ((type >> 2) * 3 + t3) * 512 + (u.pn & 1) * 256; }
        const int col0 = colt + wc * 32 + 8 * fq;
        const bool ropew = (t3 <= 1) && ((wc & 1) == 0);
#pragma unroll
        for (int ai = 0; ai < 2; ++ai)
#pragma unroll
            for (int m = 0; m < 4; ++m) {
                if ((m & 1) == 0) asm volatile("" ::: "memory");
                const int row = u.pm * BM + wr * 64 + ai * HALF + m * 16 + fr;
                const float rs = rsl[wr * 64 + ai * HALF + m * 16 + fr];
                const float sc = isq ? rs * QSCALE : rs;
                f32x4 cc = {1.f, 1.f, 1.f, 1.f}, ss = {0.f, 0.f, 0.f, 0.f};
                if (ropew && fq < 2) { const PG8_LAS f32x4* rp = (const PG8_LAS f32x4*)(rope + (wr * 64 + ai * HALF + m * 16 + fr) * 16); cc = rp[fq]; ss = rp[2 + fq]; }
                bf16_t* rowp = base + (size_t)row * ld + col0;
#pragma unroll
                for (int bj = 0; bj < 2; ++bj) {
                    f32x4 v0 = acc[ai][bj][m][0] * sc, v1 = acc[ai][bj][m][1] * sc;
                    if (ropew) {
                        const f32x4 a0 = v0, a1 = v1;
                        v0[0] = a0[0] * cc[0] - a0[1] * ss[0]; v0[1] = a0[1] * cc[0] + a0[0] * ss[0]; v0[2] = a0[2] * cc[1] - a0[3] * ss[1]; v0[3] = a0[3] * cc[1] + a0[2] * ss[1];
                        v1[0] = a1[0] * cc[2] - a1[1] * ss[2]; v1[1] = a1[1] * cc[2] + a1[0] * ss[2]; v1[2] = a1[2] * cc[3] - a1[3] * ss[3]; v1[3] = a1[3] * cc[3] + a1[2] * ss[3];
                    }
                    if (isg) {
#pragma unroll
                        for (int i = 0; i < 4; ++i) { v0[i] = v0[i] * sigm(v0[i]); v1[i] = v1[i] * sigm(v1[i]); }
                    }
                    u32x4 w; w.x = cvt_pk_bf16(v0[0], v0[1]); w.y = cvt_pk_bf16(v0[2], v0[3]); w.z = cvt_pk_bf16(v1[0], v1[1]); w.w = cvt_pk_bf16(v1[2], v1[3]);
                    *(u32x4*)(rowp + bj * HALF) = w;
                }
            }
    }
};
typedef unsigned u32x2 __attribute__((ext_vector_type(2)));
__device__ __forceinline__ f32x4 bf4(u32x2 e) { f32x4 r; r[0] = __uint_as_float(e.x << 16); r[1] = __uint_as_float(e.x & 0xffff0000u); r[2] = __uint_as_float(e.y << 16); r[3] = __uint_as_float(e.y & 0xffff0000u); return r; }
template <bool HIN_F32> struct EpiRes {
    static constexpr bool PERM = false, AFTER_DRAIN = false;
    const float* hin32; const bf16_t* hin16; bf16_t* hb; float* ssq;
    __device__ __forceinline__ void operator()(const f32x4 (&acc)[2][2][4][2], const Unit& u, int wr, int wc, int fr, int fq) const {
        const int col0 = u.pn * BM + wc * 32 + 4 * fq;
#pragma unroll
        for (int ai = 0; ai < 2; ++ai) {
            asm volatile("" ::: "memory");
            f32x4 hv[4][2][2];
#pragma unroll
            for (int m = 0; m < 4; ++m) { const size_t off = (size_t)(u.pm * BM + wr * 64 + ai * HALF + m * 16 + fr) * 1024 + col0;
#pragma unroll
                for (int bj = 0; bj < 2; ++bj)
#pragma unroll
                    for (int n = 0; n < 2; ++n) { if (HIN_F32) hv[m][bj][n] = *(const f32x4*)(hin32 + off + bj * HALF + 16 * n); else hv[m][bj][n] = bf4(*(const u32x2*)(hin16 + off + bj * HALF + 16 * n)); } }
#pragma unroll
            for (int m = 0; m < 4; ++m) {
                const int row = u.pm * BM + wr * 64 + ai * HALF + m * 16 + fr;
                const size_t off = (size_t)row * 1024 + col0; float part = 0.f;
#pragma unroll
                for (int bj = 0; bj < 2; ++bj)
#pragma unroll
                    for (int n = 0; n < 2; ++n) {
                        const f32x4 v = hv[m][bj][n] + acc[ai][bj][m][n];
                        part += (v[0] * v[0] + v[1] * v[1]) + (v[2] * v[2] + v[3] * v[3]);
                        u32x2 w; w.x = cvt_pk_bf16(v[0], v[1]); w.y = cvt_pk_bf16(v[2], v[3]);
                        *(u32x2*)(hb + off + bj * HALF + 16 * n) = w;
                    }
                part += __shfl_xor(part, 16); part += __shfl_xor(part, 32);
                if (fq == 0) ssq[(size_t)row * 16 + u.pn * 4 + wc] = part;
            }
        }
    }
};
struct EpiE {
    static constexpr bool PERM = true, AFTER_DRAIN = false;
    bf16_t* E;
    __device__ __forceinline__ void operator()(const f32x4 (&acc)[2][2][4][2], const Unit& u, int wr, int wc, int fr, int fq) const {
        const int col0 = u.pn * BM + wc * 32 + 8 * fq;
#pragma unroll
        for (int ai = 0; ai < 2; ++ai)
#pragma unroll
            for (int m = 0; m < 4; ++m) {
                const int row = u.pm * BM + wr * 64 + ai * HALF + m * 16 + fr;
#pragma unroll
                for (int bj = 0; bj < 2; ++bj) { const f32x4 v0 = acc[ai][bj][m][0], v1 = acc[ai][bj][m][1];
                    u32x4 w; w.x = cvt_pk_bf16(v0[0], v0[1]); w.y = cvt_pk_bf16(v0[2], v0[3]); w.z = cvt_pk_bf16(v1[0], v1[1]); w.w = cvt_pk_bf16(v1[2], v1[3]);
                    *(u32x4*)(E + (size_t)row * 1024 + col0 + bj * HALF) = w; }
            }
    }
};
__device__ __forceinline__ float rstd_q(const float* p, int fq) {
    const f32x4 a = ((const f32x4*)p)[fq]; float s = (a[0] + a[1]) + (a[2] + a[3]); s += __shfl_xor(s, 16); s += __shfl_xor(s, 32);
    return __builtin_amdgcn_rsqf(s * (1.0f / 1024.0f) + 1e-6f); }
struct EpiPle {
    static constexpr bool PERM = false, AFTER_DRAIN = false;
    const bf16_t* H; const bf16_t* E; bf16_t* hb; const float* ssq_in; float* ssq_out;
    __device__ __forceinline__ void operator()(const f32x4 (&acc)[2][2][4][2], const Unit& u, int wr, int wc, int fr, int fq) const {
        const int col0 = u.pn * BM + wc * 32 + 4 * fq;
#pragma unroll
        for (int ai = 0; ai < 2; ++ai) {
            asm volatile("" ::: "memory");
            u32x2 hv[4][2][2], ev[4][2][2]; float rs[4];
#pragma unroll
            for (int m = 0; m < 4; ++m) { const int row = u.pm * BM + wr * 64 + ai * HALF + m * 16 + fr; const size_t off = (size_t)row * 1024 + col0;
                rs[m] = rstd_q(ssq_in + (size_t)row * 16, fq);
#pragma unroll
                for (int bj = 0; bj < 2; ++bj)
#pragma unroll
                    for (int n = 0; n < 2; ++n) { hv[m][bj][n] = *(const u32x2*)(H + off + bj * HALF + 16 * n); ev[m][bj][n] = *(const u32x2*)(E + off + bj * HALF + 16 * n); } }
#pragma unroll
            for (int m = 0; m < 4; ++m) {
                const int row = u.pm * BM + wr * 64 + ai * HALF + m * 16 + fr;
                const size_t off = (size_t)row * 1024 + col0; float part = 0.f;
#pragma unroll
                for (int bj = 0; bj < 2; ++bj)
#pragma unroll
                    for (int n = 0; n < 2; ++n) {
                        const f32x4 a = bf4(hv[m][bj][n]), ef = bf4(ev[m][bj][n]);
                        f32x4 v;
#pragma unroll
                        for (int i = 0; i < 4; ++i) v[i] = a[i] + ef[i] * sigm(acc[ai][bj][m][n][i] * rs[m]);
                        part += (v[0] * v[0] + v[1] * v[1]) + (v[2] * v[2] + v[3] * v[3]);
                        u32x2 w; w.x = cvt_pk_bf16(v[0], v[1]); w.y = cvt_pk_bf16(v[2], v[3]);
                        *(u32x2*)(hb + off + bj * HALF + 16 * n) = w;
                    }
                part += __shfl_xor(part, 16); part += __shfl_xor(part, 32);
                if (fq == 0) ssq_out[(size_t)row * 16 + u.pn * 4 + wc] = part;
            }
        }
    }
};

struct EpiPleFinal {
    static constexpr bool PERM = false, AFTER_DRAIN = true;
    const bf16_t* H; const bf16_t* E; const float* ssq_in; float* ssq_out; unsigned* cnt; const float* gfin; float* out;
    __device__ __forceinline__ void fused(f32x4 (&acc)[2][2][4][2], const Unit& u, int wr, int wc, int fr, int fq, PG8_LAS unsigned char*, int, int lane) const {
        const int col0 = u.pn * BM + wc * 32 + 4 * fq;
#pragma unroll
        for (int ai = 0; ai < 2; ++ai)
#pragma unroll
            for (int m = 0; m < 4; ++m) {
                if ((m & 1) == 0) asm volatile("" ::: "memory");
                const int row = u.pm * BM + wr * 64 + ai * HALF + m * 16 + fr;
                const float rs = rstd_q(ssq_in + (size_t)row * 16, fq);
                const size_t off = (size_t)row * 1024 + col0; float part = 0.f;
#pragma unroll
                for (int bj = 0; bj < 2; ++bj)
#pragma unroll
                    for (int n = 0; n < 2; ++n) {
                        const f32x4 a = bf4(*(const u32x2*)(H + off + bj * HALF + 16 * n)), ef = bf4(*(const u32x2*)(E + off + bj * HALF + 16 * n));
                        f32x4 v;
#pragma unroll
                        for (int i = 0; i < 4; ++i) v[i] = a[i] + ef[i] * sigm(acc[ai][bj][m][n][i] * rs);
                        acc[ai][bj][m][n] = v;
                        part += (v[0] * v[0] + v[1] * v[1]) + (v[2] * v[2] + v[3] * v[3]);
                    }
                part += __shfl_xor(part, 16); part += __shfl_xor(part, 32);
                if (fq == 0) __hip_atomic_store(ssq_out + (size_t)row * 16 + u.pn * 4 + wc, part, __ATOMIC_RELAXED, __HIP_MEMORY_SCOPE_AGENT);
                asm volatile("" : "+v"(acc[ai][0][m][0]), "+v"(acc[ai][0][m][1]), "+v"(acc[ai][1][m][0]), "+v"(acc[ai][1][m][1]));
            }
        asm volatile("s_waitcnt vmcnt(0)" ::: "memory");
        unsigned* c = cnt + 64 * u.pm;
        if (lane == 0) __hip_atomic_fetch_add(c, 1u, __ATOMIC_RELAXED, __HIP_MEMORY_SCOPE_AGENT);
        { unsigned sp = 0;
          while ((unsigned)__builtin_amdgcn_readfirstlane(__hip_atomic_load(c, __ATOMIC_RELAXED, __HIP_MEMORY_SCOPE_AGENT)) < 32u) { __builtin_amdgcn_s_sleep(2); if (++sp > (1u << 22)) break; } }
        __builtin_amdgcn_fence(__ATOMIC_ACQUIRE, "agent");
        f32x4 g[2][2];
#pragma unroll
        for (int bj = 0; bj < 2; ++bj) { g[bj][0] = *(const f32x4*)(gfin + col0 + bj * HALF); g[bj][1] = *(const f32x4*)(gfin + col0 + bj * HALF + 16); }
#pragma unroll
        for (int ai = 0; ai < 2; ++ai)
#pragma unroll
            for (int m = 0; m < 4; ++m) {
                if (m == 0) asm volatile("" ::: "memory");
                const int row = u.pm * BM + wr * 64 + ai * HALF + m * 16 + fr;
                const float rs = rstd_q(ssq_out + (size_t)row * 16, fq);
                const size_t off = (size_t)row * 1024 + col0;
#pragma unroll
                for (int bj = 0; bj < 2; ++bj) { *(f32x4*)(out + off + bj * HALF) = acc[ai][bj][m][0] * rs * g[bj][0]; *(f32x4*)(out + off + bj * HALF + 16) = acc[ai][bj][m][1] * rs * g[bj][1]; }
            }
    }
};


template <class Epi, class Sched, bool ALIGN_EPI = false, bool SP2 = false>
__device__ __forceinline__ void gemm_phase(PG8_LAS unsigned char* lds, const Gemm g, const Sched& S, const Epi& E) {
    int tid = threadIdx.x; asm volatile("" : "+v"(tid)); const int wid = __builtin_amdgcn_readfirstlane(tid >> 6), lane = tid & 63, wr = wid >> 2, wc = wid & 3, fr = lane & 15, fq = lane >> 4;
    const int K = g.K, nt = K / BK;
    unsigned voffA[2], voffB[2];
#pragma unroll
    for (int i = 0; i < 2; ++i) { int R, C; stage_rc(tid * 16 + i * 8192, R, C); const int Rb = Epi::PERM ? ((R & ~31) + perm32(R & 31)) : R;
        voffA[i] = (unsigned)(R * K + C) * 2u; voffB[i] = (unsigned)(Rb * K + C) * 2u; }
    const size_t kstep = (size_t)(BK * 2);
    const size_t hstep = (size_t)HALF * K * 2;
    const size_t tstep = 2 * hstep;
    const unsigned ldsw = (unsigned)wid * 1024u;
    const int aoff = lds_byte(wr * 64 + fr, fq * 8), boff = lds_byte(wc * 32 + fr, fq * 8);
#define PG8_SA(b, h) (((b) * 2 + (h)) * HTB)
#define PG8_SB(b, h) ((4 + (b) * 2 + (h)) * HTB)
#define PG8_STAGE(bufoff, gbase, voff) do { _Pragma("unroll") for (int _i = 0; _i < 2; ++_i) \
        __builtin_amdgcn_global_load_lds((const unsigned*)((const char*)(gbase) + (voff)[_i]), (PG8_LAS unsigned*)(lds + (bufoff) + ldsw + _i * 8192), 16, 0, 0); } while (0)
#define PG8_LDA(dst, b, h) do { _Pragma("unroll") for (int m = 0; m < 4; ++m) _Pragma("unroll") for (int k = 0; k < 2; ++k) dst[m][k] = *(const PG8_LAS bf16x8*)(lds + PG8_SA(b, h) + aoff + m * 2048 + k * 1024); } while (0)
#define PG8_LDB(dst, b, h) do { _Pragma("unroll") for (int n = 0; n < 2; ++n) _Pragma("unroll") for (int k = 0; k < 2; ++k) dst[n][k] = *(const PG8_LAS bf16x8*)(lds + PG8_SB(b, h) + boff + n * 2048 + k * 1024); } while (0)
#define PG8_MMA(ai, bj, At, Bt) do { __builtin_amdgcn_s_setprio(1); _Pragma("unroll") for (int m = 0; m < 4; ++m) _Pragma("unroll") for (int n = 0; n < 2; ++n) _Pragma("unroll") for (int k = 0; k < 2; ++k) \
        acc[ai][bj][m][n] = __builtin_amdgcn_mfma_f32_16x16x32_bf16(Bt[n][k], At[m][k], acc[ai][bj][m][n], 0, 0, 0); __builtin_amdgcn_s_setprio(0); } while (0)
#define PG8_WAIT_V(n) asm volatile("s_waitcnt vmcnt(" #n ")" ::: "memory")
#define PG8_WAIT_L(n) asm volatile("s_waitcnt lgkmcnt(" #n ")" ::: "memory")
#define PG8_BAR __builtin_amdgcn_s_barrier()
#define PG8_SCHED __builtin_amdgcn_sched_barrier(0)
    Unit cur, nxt; int ui = 0;
    if (!S.next(0, cur)) return;
    f32x4 acc[2][2][4][2];
#pragma unroll
    for (int a = 0; a < 2; ++a)
#pragma unroll
        for (int b = 0; b < 2; ++b)
#pragma unroll
            for (int m = 0; m < 4; ++m)
#pragma unroll
                for (int n = 0; n < 2; ++n) acc[a][b][m][n] = (f32x4){0.f, 0.f, 0.f, 0.f};
    bf16x8 At[4][2], B0[2][2], B1[2][2];
    const char* cA = (const char*)g.A + (size_t)cur.pm * tstep; const char* cB = (const char*)g.Bt + (size_t)cur.pn * tstep;
    S.a_ready(cur);
    if constexpr (SP2) {
        PG8_STAGE(PG8_SB(0, 0), cB, voffB); PG8_STAGE(PG8_SB(0, 1), cB + hstep, voffB); PG8_STAGE(PG8_SA(0, 0), cA, voffA); PG8_STAGE(PG8_SA(0, 1), cA + hstep, voffA);
        if (wr == 1) PG8_BAR;
        PG8_WAIT_V(2); PG8_BAR;
        PG8_STAGE(PG8_SB(1, 0), cB + kstep, voffB); PG8_STAGE(PG8_SA(1, 0), cA + kstep, voffA); PG8_STAGE(PG8_SB(1, 1), cB + hstep + kstep, voffB);
        PG8_WAIT_V(6); PG8_BAR;
    } else {
        PG8_STAGE(PG8_SB(0, 0), cB, voffB); PG8_STAGE(PG8_SA(0, 0), cA, voffA); PG8_STAGE(PG8_SB(0, 1), cB + hstep, voffB); PG8_STAGE(PG8_SA(0, 1), cA + hstep, voffA);
        if (wr == 1) PG8_BAR;
        PG8_WAIT_V(4); PG8_BAR;
        PG8_STAGE(PG8_SB(1, 0), cB + kstep, voffB); PG8_STAGE(PG8_SA(1, 0), cA + kstep, voffA); PG8_STAGE(PG8_SB(1, 1), cB + hstep + kstep, voffB);
        PG8_WAIT_V(6); PG8_BAR;
    }
    for (;;) {
        const bool has_next = S.next(ui + 1, nxt);
        const char* nA = has_next ? (const char*)g.A + (size_t)nxt.pm * tstep : cA; const char* nB = has_next ? (const char*)g.Bt + (size_t)nxt.pn * tstep : cB;
        for (int t = 0; t < nt; t += 2) {
            const bool last = (t == nt - 2);
            const char* a1 = cA + (size_t)(t + 1) * kstep;
            const char* a2 = last ? nA : cA + (size_t)(t + 2) * kstep; const char* b2 = last ? nB : cB + (size_t)(t + 2) * kstep;
            const char* a3 = a2 + kstep; const char* b3 = b2 + kstep;
            if (last && has_next) S.a_ready(nxt);
            if constexpr (SP2) {
            PG8_LDB(B0, 0, 0); PG8_LDB(B1, 0, 1); PG8_SCHED; PG8_LDA(At, 0, 0); PG8_STAGE(PG8_SA(1, 1), a1 + hstep, voffA);
            PG8_WAIT_V(8); PG8_WAIT_L(0); PG8_BAR; PG8_MMA(0, 0, At, B0); PG8_MMA(0, 1, At, B1); PG8_BAR; PG8_SCHED;
            PG8_LDA(At, 0, 1); PG8_STAGE(PG8_SB(0, 0), b2, voffB); PG8_STAGE(PG8_SB(0, 1), b2 + hstep, voffB); PG8_STAGE(PG8_SA(0, 0), a2, voffA);
            PG8_WAIT_V(8); PG8_WAIT_L(0); PG8_BAR; PG8_MMA(1, 0, At, B0); PG8_MMA(1, 1, At, B1); PG8_BAR; PG8_SCHED;
            PG8_LDB(B0, 1, 0); PG8_LDB(B1, 1, 1); PG8_SCHED; PG8_LDA(At, 1, 0); PG8_STAGE(PG8_SA(0, 1), a2 + hstep, voffA);
            PG8_WAIT_V(8); PG8_WAIT_L(0); PG8_BAR; PG8_MMA(0, 0, At, B0); PG8_MMA(0, 1, At, B1); PG8_BAR; PG8_SCHED;
            PG8_LDA(At, 1, 1); PG8_STAGE(PG8_SB(1, 0), b3, voffB); PG8_STAGE(PG8_SB(1, 1), b3 + hstep, voffB); PG8_STAGE(PG8_SA(1, 0), a3, voffA);
            PG8_WAIT_V(8); PG8_WAIT_L(0); PG8_BAR; PG8_MMA(1, 0, At, B0); PG8_MMA(1, 1, At, B1); PG8_BAR; PG8_SCHED;
            } else {
            PG8_LDB(B0, 0, 0); PG8_SCHED; PG8_LDA(At, 0, 0); PG8_STAGE(PG8_SA(1, 1), a1 + hstep, voffA);
            PG8_WAIT_L(8); PG8_BAR; PG8_WAIT_L(0); PG8_MMA(0, 0, At, B0); PG8_BAR; PG8_SCHED;
            PG8_LDB(B1, 0, 1); PG8_STAGE(PG8_SB(0, 0), b2, voffB);
            PG8_BAR; PG8_WAIT_L(0); PG8_MMA(0, 1, At, B1); PG8_BAR;
            PG8_LDA(At, 0, 1); PG8_STAGE(PG8_SA(0, 0), a2, voffA);
            PG8_BAR; PG8_WAIT_L(0); PG8_MMA(1, 0, At, B0); PG8_BAR; PG8_SCHED;
            PG8_STAGE(PG8_SB(0, 1), b2 + hstep, voffB);
            PG8_WAIT_V(6); PG8_BAR; PG8_MMA(1, 1, At, B1); PG8_BAR;
            PG8_LDB(B0, 1, 0); PG8_SCHED; PG8_LDA(At, 1, 0); PG8_STAGE(PG8_SA(0, 1), a2 + hstep, voffA);
            PG8_WAIT_L(8); PG8_BAR; PG8_WAIT_L(0); PG8_MMA(0, 0, At, B0); PG8_BAR; PG8_SCHED;
            PG8_LDB(B1, 1, 1); PG8_STAGE(PG8_SB(1, 0), b3, voffB);
            PG8_BAR; PG8_WAIT_L(0); PG8_MMA(0, 1, At, B1); PG8_BAR;
            PG8_LDA(At, 1, 1); PG8_STAGE(PG8_SA(1, 0), a3, voffA);
            PG8_BAR; PG8_WAIT_L(0); PG8_MMA(1, 0, At, B0); PG8_BAR; PG8_SCHED;
            PG8_STAGE(PG8_SB(1, 1), b3 + hstep, voffB);
            PG8_WAIT_V(6); PG8_BAR; PG8_MMA(1, 1, At, B1); PG8_BAR;
            }
        }
        if constexpr (ALIGN_EPI) { if (wr == 0) PG8_BAR; }
        if constexpr (!Epi::AFTER_DRAIN) { E(acc, cur, wr, wc, fr, fq); S.done(cur); }
        if (!has_next) break;
#pragma unroll
        for (int a = 0; a < 2; ++a)
#pragma unroll
            for (int b = 0; b < 2; ++b)
#pragma unroll
                for (int m = 0; m < 4; ++m)
#pragma unroll
                    for (int n = 0; n < 2; ++n) acc[a][b][m][n] = (f32x4){0.f, 0.f, 0.f, 0.f};
        cur = nxt; cA = nA; cB = nB; ++ui;
        if constexpr (ALIGN_EPI) { if (wr == 1) PG8_BAR; }
    }
    PG8_WAIT_V(0);
    if constexpr (!ALIGN_EPI) { if (wr == 0) PG8_BAR; }
    PG8_BAR;
    if constexpr (Epi::AFTER_DRAIN) { E.fused(acc, cur, wr, wc, fr, fq, lds, wid, lane); S.done(cur); }
#undef PG8_SA
#undef PG8_SB
#undef PG8_STAGE
#undef PG8_LDA
#undef PG8_LDB
#undef PG8_MMA
#undef PG8_WAIT_V
#undef PG8_WAIT_L
#undef PG8_BAR
#undef PG8_SCHED
}
}

#ifndef PG8_SP2
#define PG8_SP2 true
#endif
#ifndef PG8_ALIGN
#define PG8_ALIGN true
#endif
#include <hip/hip_bf16.h>
#include <cmath>
namespace attn_body {
using bf16=__hip_bfloat16;
using bf16x8=__attribute__((ext_vector_type(8)))short;
using s16x4=__attribute__((ext_vector_type(4)))short;
using f32x16=__attribute__((ext_vector_type(16)))float;
using u32x4=__attribute__((ext_vector_type(4)))unsigned;
constexpr int BATCH=2,SEQ=8192,D=64;
constexpr int NW=8,QBLK=32,QB=QBLK*NW,KVBLK=64;
__device__ __forceinline__ int crow(int r,int hi){return (r&3)+8*(r>>2)+4*hi;}
#define SBAR() __builtin_amdgcn_sched_barrier(0)
template<int MODE> __device__ __forceinline__ void amask(f32x16&p0,f32x16&p1,int t,int NT,int joff,int qrel,int hi){
  const float NEG=-INFINITY;
  if(MODE==0){ const int jb=t-(NT-4); if(jb<0)return; const int kb=64*jb+4*hi;
    #pragma unroll
    for(int r=0;r<16;++r){int kv=kb+(r&3)+8*(r>>2); if(kv>qrel)p0[r]=NEG; if(kv+32>qrel)p1[r]=NEG;}
  } else { const int kb=64*(t+joff)+4*hi-qrel;
    #pragma unroll
    for(int r=0;r<16;++r){int dv=kb+(r&3)+8*(r>>2); if((unsigned)dv>128u)p0[r]=NEG; if((unsigned)(dv+32)>128u)p1[r]=NEG;}
  }
}

constexpr int NSLOT=3, SLOTB=8192;
constexpr int LDS_K=0, LDS_V=NSLOT*SLOTB, LDS_WS=2*NSLOT*SLOTB, LDS_OST=LDS_WS+NW*64*4, LDS_BYTES=LDS_OST+NW*4096;
constexpr float C2=0.125f*1.4426950408889634f;
__device__ __forceinline__ void glds16(const void*sbase,unsigned voff,unsigned lds_dst){unsigned keep;
  asm volatile("s_mov_b32 %0, m0\n\ts_mov_b32 m0, %3\n\ts_nop 0\n\tglobal_load_lds_dwordx4 %1, %2\n\ts_mov_b32 m0, %0":"=&s"(keep):"v"(voff),"s"(sbase),"s"(lds_dst):"memory");}
__device__ __forceinline__ float max3f(float a,float b,float c){float r;asm("v_max3_f32 %0, %1, %2, %3":"=v"(r):"v"(a),"v"(b),"v"(c));return r;}
__device__ __forceinline__ float max2f(float a,float b){float r;asm("v_max_f32_e32 %0, %1, %2":"=v"(r):"v"(a),"v"(b));return r;}
__device__ __forceinline__ float fadd_s(float a,float b){float r;asm("v_add_f32_e32 %0, %1, %2":"=v"(r):"v"(a),"v"(b));return r;}
__device__ __forceinline__ float fsub_s(float a,float b){float r;asm("v_sub_f32_e32 %0, %1, %2":"=v"(r):"v"(a),"v"(b));return r;}
typedef float f32x2_t __attribute__((ext_vector_type(2))); typedef __bf16 bf16x2_t __attribute__((ext_vector_type(2)));
__device__ __forceinline__ unsigned cvtpk_s(float lo,float hi){f32x2_t v={lo,hi};bf16x2_t b=__builtin_convertvector(v,bf16x2_t);return __builtin_bit_cast(unsigned,b);}
#define WAIT_BAR(N) asm volatile("s_waitcnt vmcnt(" #N ") lgkmcnt(0)\n\ts_barrier":::"memory")

__device__ __forceinline__ void qkt(f32x16&p0,f32x16&p1,const char*Kslot,const bf16x8*qr,const f32x16&negm,int r32,int hi){
  const char*kb=Kslot+hi*1024+r32*16;
  #pragma unroll
  for(int d0=0;d0<4;++d0){
    const bf16x8 b0=*reinterpret_cast<const bf16x8*>(kb+d0*2048);
    const bf16x8 b1=*reinterpret_cast<const bf16x8*>(kb+d0*2048+512);
    if(d0==0){p0=__builtin_amdgcn_mfma_f32_32x32x16_bf16(b0,qr[0],negm,0,0,0);p1=__builtin_amdgcn_mfma_f32_32x32x16_bf16(b1,qr[0],negm,0,0,0);}
    else{p0=__builtin_amdgcn_mfma_f32_32x32x16_bf16(b0,qr[d0],p0,0,0,0);p1=__builtin_amdgcn_mfma_f32_32x32x16_bf16(b1,qr[d0],p1,0,0,0);}}
}
typedef __attribute__((address_space(3))) const char* lds_cptr;
typedef short v4i16_t __attribute__((ext_vector_type(4)));
__device__ __forceinline__ void kload8(bf16x8*kf,lds_cptr kp){
  kf[0]=*(const __attribute__((address_space(3))) bf16x8*)(kp);      kf[1]=*(const __attribute__((address_space(3))) bf16x8*)(kp+512);
  kf[2]=*(const __attribute__((address_space(3))) bf16x8*)(kp+2048); kf[3]=*(const __attribute__((address_space(3))) bf16x8*)(kp+2560);
  kf[4]=*(const __attribute__((address_space(3))) bf16x8*)(kp+4096); kf[5]=*(const __attribute__((address_space(3))) bf16x8*)(kp+4608);
  kf[6]=*(const __attribute__((address_space(3))) bf16x8*)(kp+6144); kf[7]=*(const __attribute__((address_space(3))) bf16x8*)(kp+6656);
}
__device__ __forceinline__ void kload2(bf16x8*kf,lds_cptr kp,int j){ kf[2*j]=*(const __attribute__((address_space(3))) bf16x8*)(kp+j*2048); kf[2*j+1]=*(const __attribute__((address_space(3))) bf16x8*)(kp+j*2048+512); }
__device__ __forceinline__ s16x4 vtr(lds_cptr p){ return __builtin_bit_cast(s16x4,__builtin_amdgcn_ds_read_tr16_b64_v4i16((__attribute__((address_space(3))) v4i16_t*)p)); }
__device__ __forceinline__ float rowmax(const f32x16&p0,const f32x16&p1){
  float a=max3f(p0[0],p0[1],p1[0]),b=max3f(p0[2],p0[3],p1[1]);a=max3f(a,p1[2],p1[3]);
  #pragma unroll
  for(int r=4;r<16;r+=4){a=max3f(a,p0[r],p0[r+1]);b=max3f(b,p0[r+2],p0[r+3]);a=max3f(a,p1[r],p1[r+1]);b=max3f(b,p1[r+2],p1[r+3]);}
  const float m=max2f(a,b);
  auto rr=__builtin_amdgcn_permlane32_swap(__float_as_uint(m),__float_as_uint(m),false,false);
  return max2f(__uint_as_float(rr[0]),__uint_as_float(rr[1]));
}
__device__ __forceinline__ void pv(f32x16*o,int vb,bf16x8 pa0,bf16x8 pa1,bf16x8 pa2,bf16x8 pa3){
  #pragma unroll
  for(int d0=0;d0<2;++d0){s16x4 lo[4],hi[4];
    #pragma unroll
    for(int ks=0;ks<4;++ks){
      asm volatile("ds_read_b64_tr_b16 %0,%1 offset:%c2":"=&v"(lo[ks]):"v"(vb),"i"(d0*4096+ks*1024):"memory");
      asm volatile("ds_read_b64_tr_b16 %0,%1 offset:%c2":"=&v"(hi[ks]):"v"(vb),"i"(d0*4096+ks*1024+512):"memory");}
    asm volatile("s_waitcnt lgkmcnt(0)":::"memory");SBAR();
    #define PK(k) (bf16x8){lo[k][0],lo[k][1],lo[k][2],lo[k][3],hi[k][0],hi[k][1],hi[k][2],hi[k][3]}
    o[d0]=__builtin_amdgcn_mfma_f32_32x32x16_bf16(pa0,PK(0),o[d0],0,0,0);
    o[d0]=__builtin_amdgcn_mfma_f32_32x32x16_bf16(pa1,PK(1),o[d0],0,0,0);
    o[d0]=__builtin_amdgcn_mfma_f32_32x32x16_bf16(pa2,PK(2),o[d0],0,0,0);
    o[d0]=__builtin_amdgcn_mfma_f32_32x32x16_bf16(pa3,PK(3),o[d0],0,0,0);
    #undef PK
  }
}

#ifndef ATTN_STORE16
#define ATTN_STORE16(p,v) (*(u32x4*)(p)=(v))
#endif
template<int MODE,int THRL,int qstride,int kvstride,int ostride,int lsestride> __device__ __forceinline__ void attn_unit(const bf16*Q0,const bf16*__restrict__ K0,const bf16*__restrict__ V0,bf16*O0,float*lsep,const int NT,const int joff,char*shm){
  int tid=threadIdx.x; asm volatile("":"+v"(tid)); const int lane=tid&63,r32=lane&31,hi=lane>>5; const int wid=__builtin_amdgcn_readfirstlane(tid>>6);
  const bf16*Qw=Q0+(wid*QBLK)*qstride;
  const bf16*Kh=K0,*Vh=V0;
  const unsigned lds0=(unsigned)(uintptr_t)shm;
  float*wsf=(float*)(shm+LDS_WS)+wid*64;
  const unsigned kvo=(unsigned)(lane*kvstride+wid*8)*2u;
  const unsigned vvo=(unsigned)((16*(wid&3)+(lane>>2))*kvstride+(wid>>2)*32+(lane&3)*8)*2u;
  const unsigned kdst=lds0+LDS_K+wid*1024, vdst=lds0+LDS_V+wid*1024;
  #define DMA_K(t,slot) glds16(Kh+(t)*KVBLK*kvstride,kvo,(unsigned)__builtin_amdgcn_readfirstlane(kdst+(slot)))
  #define DMA_V(t,slot) glds16(Vh+(t)*KVBLK*kvstride,vvo,(unsigned)__builtin_amdgcn_readfirstlane(vdst+(slot)))
  const int vb0=(int)(lds0+LDS_V)+((lane>>4)&1)*32+(lane&3)*8+(4*hi+((lane&15)>>2))*64;
  const char*Kbase=shm+LDS_K; bf16x8 kf[8];
  const lds_cptr shm3=(lds_cptr)shm; const lds_cptr kp0=shm3+LDS_K+hi*1024+r32*16; const lds_cptr vp0=shm3+LDS_V+((lane>>4)&1)*32+(lane&3)*8+(4*hi+((lane&15)>>2))*64;
  DMA_K(0,0);DMA_V(0,0);DMA_K(1,SLOTB);
  bf16x8 qr[4];
  #pragma unroll
  for(int d0=0;d0<4;++d0)qr[d0]=*reinterpret_cast<const bf16x8*>(&Qw[r32*qstride+d0*16+hi*8]);
  float mhat=0.f,l_reg=0.f;f32x16 o[2];o[0]=f32x16{};o[1]=f32x16{};f32x16 negm=f32x16{};asm volatile("":"+v"(negm));
  const int qrel=wid*QBLK+r32;
  #define CMASK(P0,P1,t) amask<MODE>(P0,P1,(t),NT,joff,qrel,hi)
  bool resc=false;
  #define START(P0,P1) do{ const float rm=rowmax(P0,P1); resc=false; \
    { const float dl=(MODE==1&&rm<-1e30f)?0.f:rm; mhat=fadd_s(mhat,dl); \
      _Pragma("unroll") for(int r=0;r<16;++r){P0[r]=fsub_s(P0[r],dl);P1[r]=fsub_s(P1[r],dl);} \
      _Pragma("unroll") for(int r=0;r<16;++r)negm[r]=-mhat; asm volatile("":"+v"(negm)); } \
    _Pragma("unroll") for(int r=0;r<16;++r)P0[r]=__builtin_amdgcn_exp2f(P0[r]); }while(0)
  #define RESC() do{ if(resc){ asm volatile("s_waitcnt lgkmcnt(0)":::"memory"); \
      _Pragma("unroll") for(int d_=0;d_<2;++d_) _Pragma("unroll") for(int r=0;r<16;++r)o[d_][r]*=wsf[crow(r,hi)]; } }while(0)
  f32x16 pA0,pA1,pB0,pB1;
  int sl_prev=0,sl_cur=0,sl_next=SLOTB;
  #define ROT() do{sl_prev=sl_cur;sl_cur=sl_next;sl_next=(sl_next==(NSLOT-1)*SLOTB)?0:sl_next+SLOTB;}while(0)
  DMA_K(2,2*SLOTB);
  WAIT_BAR(3);
  const int t_lo_=(wid>>1)-joff, t_lo=(MODE==1)?(t_lo_<0?0:t_lo_):0, t_hi=(MODE==1)?(t_lo_+2):(NT-1);
  if(t_lo==0){
    qkt(pA0,pA1,Kbase,qr,negm,r32,hi);asm volatile("s_nop 15\n\ts_nop 7":"+v"(pA0),"+v"(pA1));CMASK(pA0,pA1,0);
    START(pA0,pA1);
    _Pragma("unroll") for(int r=0;r<16;++r)pA1[r]=__builtin_amdgcn_exp2f(pA1[r]);
  }
  WAIT_BAR(0);
  DMA_K(3,0);DMA_V(1,SLOTB);
  ROT();
  if(t_lo<=1&&1<=t_hi)kload8(kf,kp0+sl_cur);
  WAIT_BAR(2);
  s16x4 vlo[8],vhi[8]; u32x4 pw0,pw1,pw2,pw3;
  #define PKW(P,B) cvtpk_s(P[B],P[B+1])
  #define PAF(k) __builtin_bit_cast(bf16x8,pw##k)
  #define VFR(i) (bf16x8){vlo[i][0],vlo[i][1],vlo[i][2],vlo[i][3],vhi[i][0],vhi[i][1],vhi[i][2],vhi[i][3]}
  #define PIN(x) asm volatile("":"+v"(x))
  #define MX3(a,b,c) __builtin_fmaxf(__builtin_fmaxf((a),(b)),(c))
  #define GAPA(MF,A0,A1,A2,A3,W0,W1,PW) do{ MF; sacc+=A0; sacc+=A1; sacc+=A2; sacc+=A3; PIN(sacc); W0; W1; PIN(PW); SBAR(); }while(0)
  #define EX(v) __builtin_amdgcn_exp2f(v)
  #define GAPB(MF,X,B) do{ MF; X[B]=EX(X[B]); X[B+1]=EX(X[B+1]); X[B+2]=EX(X[B+2]); X[B+3]=EX(X[B+3]); PIN(X); SBAR(); }while(0)
  #define VRD(i) do{ vlo[i]=vtr(vp_+(((i)>>2)*4096+((i)&3)*1024)); vhi[i]=vtr(vp_+(((i)>>2)*4096+((i)&3)*1024+512)); }while(0)
  #define KRD(G,j) do{ if(G){ kload2(kf,kp0+sl_next,j); SBAR(); } }while(0)
  #define STEP(C0,C1,P0,P1,t,GK,GV,GL) do{ SBAR(); \
    const lds_cptr vp_=vp0+sl_prev; \
    VRD(0); SBAR(); float sacc=(P0[0]+P0[1]); \
    GAPA(C0=__builtin_amdgcn_mfma_f32_32x32x16_bf16(kf[0],qr[0],negm,0,0,0), P0[2],P0[3],P0[4],P0[5],     pw0[0]=PKW(P0,0), pw0[1]=PKW(P0,2), pw0); \
    VRD(4); SBAR(); GAPA(C1=__builtin_amdgcn_mfma_f32_32x32x16_bf16(kf[1],qr[0],negm,0,0,0), P0[6],P0[7],P0[8],P0[9],     pw0[2]=PKW(P0,4), pw0[3]=PKW(P0,6), pw0); \
    VRD(1); SBAR(); GAPA(C0=__builtin_amdgcn_mfma_f32_32x32x16_bf16(kf[2],qr[1],C0,0,0,0),   P0[10],P0[11],P0[12],P0[13], pw1[0]=PKW(P0,8), pw1[1]=PKW(P0,10), pw1); \
    VRD(5); SBAR(); GAPA(C1=__builtin_amdgcn_mfma_f32_32x32x16_bf16(kf[3],qr[1],C1,0,0,0),   P0[14],P0[15],P1[0],P1[1],   pw1[2]=PKW(P0,12),pw1[3]=PKW(P0,14), pw1); \
    VRD(2); SBAR(); GAPA(C0=__builtin_amdgcn_mfma_f32_32x32x16_bf16(kf[4],qr[2],C0,0,0,0),   P1[2],P1[3],P1[4],P1[5],     pw2[0]=PKW(P1,0), pw2[1]=PKW(P1,2), pw2); \
    VRD(6); SBAR(); GAPA(C1=__builtin_amdgcn_mfma_f32_32x32x16_bf16(kf[5],qr[2],C1,0,0,0),   P1[6],P1[7],P1[8],P1[9],     pw2[2]=PKW(P1,4), pw2[3]=PKW(P1,6), pw2); \
    VRD(3); SBAR(); GAPA(C0=__builtin_amdgcn_mfma_f32_32x32x16_bf16(kf[6],qr[3],C0,0,0,0),   P1[10],P1[11],P1[12],P1[13], pw3[0]=PKW(P1,8), pw3[1]=PKW(P1,10), pw3); \
    VRD(7); SBAR(); GAPA(C1=__builtin_amdgcn_mfma_f32_32x32x16_bf16(kf[7],qr[3],C1,0,0,0),   P1[14],P1[15],0.f,0.f,       pw3[2]=PKW(P1,12),pw3[3]=PKW(P1,14), pw3); \
    l_reg+=sacc; \
    if(GK){DMA_K((t)+3,sl_cur);} if(GV){DMA_V((t)+1,sl_next);} \
    CMASK(C0,C1,t); \
    { float a=MX3(C0[0],C0[1],C1[0]),b=MX3(C0[2],C0[3],C1[1]); a=MX3(a,C1[2],C1[3]); \
      _Pragma("unroll") for(int r=4;r<16;r+=4){a=MX3(a,C0[r],C0[r+1]);b=MX3(b,C0[r+2],C0[r+3]);a=MX3(a,C1[r],C1[r+1]);b=MX3(b,C1[r+2],C1[r+3]);} \
      float rm=__builtin_fmaxf(a,b); { auto rr=__builtin_amdgcn_permlane32_swap(__float_as_uint(rm),__float_as_uint(rm),false,false); rm=__builtin_fmaxf(__uint_as_float(rr[0]),__uint_as_float(rr[1])); } \
      resc=false; \
      if(__builtin_expect(__any(rm>(float)THRL),0)){ const float dl=__builtin_fmaxf(rm,0.f); mhat+=dl; \
        _Pragma("unroll") for(int r=0;r<16;++r){C0[r]-=dl;C1[r]-=dl;} \
        _Pragma("unroll") for(int r=0;r<16;++r)negm[r]=-mhat; asm volatile("":"+v"(negm)); \
        const float f=__builtin_amdgcn_exp2f(-dl); l_reg*=f; if(hi==0)wsf[r32]=f; resc=true; } } \
    SBAR(); \
    GAPB(o[0]=__builtin_amdgcn_mfma_f32_32x32x16_bf16(PAF(0),VFR(0),o[0],0,0,0), C0,0); \
    GAPB(o[1]=__builtin_amdgcn_mfma_f32_32x32x16_bf16(PAF(0),VFR(4),o[1],0,0,0), C0,4); \
    KRD(GL,0); GAPB(o[0]=__builtin_amdgcn_mfma_f32_32x32x16_bf16(PAF(1),VFR(1),o[0],0,0,0), C0,8); \
    KRD(GL,1); GAPB(o[1]=__builtin_amdgcn_mfma_f32_32x32x16_bf16(PAF(1),VFR(5),o[1],0,0,0), C0,12); \
    KRD(GL,2); GAPB(o[0]=__builtin_amdgcn_mfma_f32_32x32x16_bf16(PAF(2),VFR(2),o[0],0,0,0), C1,0); \
    KRD(GL,3); GAPB(o[1]=__builtin_amdgcn_mfma_f32_32x32x16_bf16(PAF(2),VFR(6),o[1],0,0,0), C1,4); \
    GAPB(o[0]=__builtin_amdgcn_mfma_f32_32x32x16_bf16(PAF(3),VFR(3),o[0],0,0,0), C1,8); \
    GAPB(o[1]=__builtin_amdgcn_mfma_f32_32x32x16_bf16(PAF(3),VFR(7),o[1],0,0,0), C1,12); \
    }while(0)
  #define ENDW(tt) do{ if((tt)+3<NT){WAIT_BAR(2);} else if((tt)+2<NT){WAIT_BAR(1);} else {WAIT_BAR(0);} }while(0)
  #define PVONLY(P0,P1,slot) do{ float sacc=P0[0]+P0[1]; _Pragma("unroll") for(int r=2;r<16;++r)sacc+=P0[r]; _Pragma("unroll") for(int r=0;r<16;++r)sacc+=P1[r]; l_reg+=sacc; \
    pw0=(u32x4){PKW(P0,0),PKW(P0,2),PKW(P0,4),PKW(P0,6)};pw1=(u32x4){PKW(P0,8),PKW(P0,10),PKW(P0,12),PKW(P0,14)};pw2=(u32x4){PKW(P1,0),PKW(P1,2),PKW(P1,4),PKW(P1,6)};pw3=(u32x4){PKW(P1,8),PKW(P1,10),PKW(P1,12),PKW(P1,14)}; \
    SBAR(); pv(o,vb0+(slot),PAF(0),PAF(1),PAF(2),PAF(3)); }while(0)
  if constexpr(MODE==0){
  int t=1;
  #undef CMASK
  #define CMASK(P0,P1,t) do{}while(0)
  for(;t+5<NT;t+=2){
    STEP(pB0,pB1,pA0,pA1,t,true,true,true);     WAIT_BAR(2); RESC(); ROT();
    STEP(pA0,pA1,pB0,pB1,t+1,true,true,true);   WAIT_BAR(2); RESC(); ROT();
  }
  #undef CMASK
  #define CMASK(P0,P1,t) amask<MODE>(P0,P1,(t),NT,joff,qrel,hi)
  for(;t+1<NT;t+=2){
    STEP(pB0,pB1,pA0,pA1,t,(t+3<NT),(t+1<NT),(t+1<NT));       ENDW(t);   RESC(); ROT();
    STEP(pA0,pA1,pB0,pB1,t+1,(t+4<NT),(t+2<NT),(t+2<NT));     ENDW(t+1); RESC(); ROT();
  }
  STEP(pB0,pB1,pA0,pA1,NT-1,false,false,false); RESC();
  PVONLY(pB0,pB1,sl_cur);
  } else {
  #define QK8(C0,C1) do{ \
    C0=__builtin_amdgcn_mfma_f32_32x32x16_bf16(kf[0],qr[0],negm,0,0,0);C1=__builtin_amdgcn_mfma_f32_32x32x16_bf16(kf[1],qr[0],negm,0,0,0); \
    C0=__builtin_amdgcn_mfma_f32_32x32x16_bf16(kf[2],qr[1],C0,0,0,0);C1=__builtin_amdgcn_mfma_f32_32x32x16_bf16(kf[3],qr[1],C1,0,0,0); \
    C0=__builtin_amdgcn_mfma_f32_32x32x16_bf16(kf[4],qr[2],C0,0,0,0);C1=__builtin_amdgcn_mfma_f32_32x32x16_bf16(kf[5],qr[2],C1,0,0,0); \
    C0=__builtin_amdgcn_mfma_f32_32x32x16_bf16(kf[6],qr[3],C0,0,0,0);C1=__builtin_amdgcn_mfma_f32_32x32x16_bf16(kf[7],qr[3],C1,0,0,0); \
    asm volatile("s_nop 15\n\ts_nop 7":"+v"(C0),"+v"(C1)); }while(0)
  #define QKONLY(C0,C1,s) do{ QK8(C0,C1); CMASK(C0,C1,s); START(C0,C1); \
    _Pragma("unroll") for(int r=0;r<16;++r)C1[r]=__builtin_amdgcn_exp2f(C1[r]); }while(0)
  #define QKNEXT(C0,C1,s) do{ QK8(C0,C1); CMASK(C0,C1,s); \
    { float rm=rowmax(C0,C1); \
      if(__builtin_expect(__any(rm>(float)THRL),0)){ const float dl=__builtin_fmaxf(rm,0.f); mhat+=dl; \
        _Pragma("unroll") for(int r=0;r<16;++r){C0[r]-=dl;C1[r]-=dl;} \
        _Pragma("unroll") for(int r=0;r<16;++r)negm[r]=-mhat; asm volatile("":"+v"(negm)); \
        const float f=__builtin_amdgcn_exp2f(-dl); l_reg*=f; if(hi==0)wsf[r32]=f; resc=true; } } \
    _Pragma("unroll") for(int r=0;r<16;++r){C0[r]=__builtin_amdgcn_exp2f(C0[r]);C1[r]=__builtin_amdgcn_exp2f(C1[r]);} }while(0)
  for(int s=1;s<NT;++s){
    const bool qk_=(t_lo<=s)&&(s<=t_hi), pv_=(t_lo<=s-1)&&(s-1<=t_hi), kn_=(t_lo<=s+1)&&(s+1<=t_hi); resc=false;
    if(pv_){ PVONLY(pA0,pA1,sl_prev); }
    if(qk_){ if(s==t_lo){ QKONLY(pA0,pA1,s); } else { QKNEXT(pA0,pA1,s); } }
    if(s+3<NT){DMA_K(s+3,sl_cur);} if(s+1<NT){DMA_V(s+1,sl_next);}
    if(kn_){ kload8(kf,kp0+sl_next); }
    ENDW(s); RESC(); ROT();
  }
  if(t_hi==NT-1){ PVONLY(pA0,pA1,sl_prev); }
  #undef QK8
  #undef QKNEXT
  #undef QKONLY
  }
  #undef PVONLY
  #undef PKW
  #undef PAF
  #undef VFR
  #undef PIN
  #undef MX3
  #undef GAPA
  #undef GAPB
  #undef EX
  #undef VRD
  #undef KRD
  #undef STEP
  #undef ENDW
  {auto rr=__builtin_amdgcn_permlane32_swap(__float_as_uint(l_reg),__float_as_uint(l_reg),false,false);l_reg=__uint_as_float(rr[0])+__uint_as_float(rr[1]);}
  if(hi==0){wsf[32+r32]=l_reg; if(lsep)lsep[(wid*QBLK+r32)*lsestride]=mhat+__builtin_amdgcn_logf(l_reg);}asm volatile("s_waitcnt lgkmcnt(0)":::"memory");
  float rli[16];
  #pragma unroll
  for(int r=0;r<16;++r)rli[r]=__builtin_amdgcn_rcpf(wsf[32+crow(r,hi)]);
  bf16*Ow=O0+(wid*QBLK)*ostride;
  { bf16*stg=(bf16*)(shm+LDS_OST)+wid*2048;
    #pragma unroll
    for(int r=0;r<16;++r){const int orow=crow(r,hi);
      #pragma unroll
      for(int d0=0;d0<2;++d0)stg[orow*64+d0*32+r32]=__float2bfloat16(o[d0][r]*rli[r]);}
    asm volatile("s_waitcnt lgkmcnt(0)":::"memory");
    #pragma unroll
    for(int i=0;i<4;++i){const int row=i*8+(lane>>3),ch=lane&7; const u32x4 v=*(const u32x4*)(stg+row*64+ch*8); ATTN_STORE16(Ow+row*ostride+ch*8,v);} }
  asm volatile("s_waitcnt lgkmcnt(0)\n\ts_barrier":::"memory");
  #undef DMA_K
  #undef DMA_V
  #undef CMASK
  #undef START
  #undef RESC
  #undef ROT
}
constexpr int VSLOTB=16384, LDS2_K=0, LDS2_V=NSLOT*SLOTB, LDS2_WS=LDS2_V+NSLOT*VSLOTB, LDS2_OST=LDS2_WS+NW*64*4, LDS2_BYTES=LDS2_OST+NW*4096;
__device__ __forceinline__ f32x2_t pk_sub(f32x2_t a,f32x2_t b){f32x2_t r;asm("v_pk_add_f32 %0, %1, %2 neg_lo:[0,1] neg_hi:[0,1]":"=v"(r):"v"(a),"v"(b));return r;}
__device__ __forceinline__ f32x2_t pk_add(f32x2_t a,f32x2_t b){f32x2_t r;asm("v_pk_add_f32 %0, %1, %2":"=v"(r):"v"(a),"v"(b));return r;}
template<int THRL,int qstride,int kvstride,int ostride> __device__ __forceinline__ void attn_unit128(const bf16*Q0,const bf16*__restrict__ K0,const bf16*__restrict__ V0,bf16*O0,const int NT,char*shm){
  int tid=threadIdx.x; asm volatile("":"+v"(tid)); const int lane=tid&63,r32=lane&31,hi=lane>>5; const int wid=__builtin_amdgcn_readfirstlane(tid>>6);
  const bf16*Qw=Q0+(wid*QBLK)*qstride;
  const bf16*Kh=K0,*Vh=V0;
  const unsigned lds0=(unsigned)(uintptr_t)shm;
  float*wsf=(float*)(shm+LDS2_WS)+wid*64;
  const unsigned kvo=(unsigned)(lane*kvstride+wid*8)*2u;
  const unsigned vvo=(unsigned)((16*(wid&3)+(lane>>2))*kvstride+(wid>>2)*32+(lane&3)*8)*2u;
  const unsigned kdst=lds0+LDS2_K+wid*1024, vdst=lds0+LDS2_V+wid*1024;
  #define DMA_K(t,slot) glds16(Kh+(t)*KVBLK*kvstride,kvo,(unsigned)__builtin_amdgcn_readfirstlane(kdst+(slot)))
  #define DMA_V(t,slot) do{ glds16(Vh+(t)*KVBLK*kvstride,vvo,(unsigned)__builtin_amdgcn_readfirstlane(vdst+2*(slot))); glds16(Vh+(t)*KVBLK*kvstride+64,vvo,(unsigned)__builtin_amdgcn_readfirstlane(vdst+2*(slot)+8192)); }while(0)
  const int vb0=(int)(lds0+LDS2_V)+((lane>>4)&1)*32+(lane&3)*8+(4*hi+((lane&15)>>2))*64;
  bf16x8 kf[8];
  const lds_cptr shm3=(lds_cptr)shm; const lds_cptr kp0=shm3+LDS2_K+hi*1024+r32*16; const lds_cptr vp0=shm3+LDS2_V+((lane>>4)&1)*32+(lane&3)*8+(4*hi+((lane&15)>>2))*64;
  DMA_K(0,0);DMA_V(0,0);DMA_K(1,SLOTB);
  bf16x8 qr[4];
  #pragma unroll
  for(int d0=0;d0<4;++d0)qr[d0]=*reinterpret_cast<const bf16x8*>(&Qw[r32*qstride+d0*16+hi*8]);
  float mhat=0.f,l_reg=0.f;f32x16 o[4];o[0]=f32x16{};o[1]=f32x16{};o[2]=f32x16{};o[3]=f32x16{};
  const int qrel=wid*QBLK+r32;
  #define BFR(x) __uint_as_float(cvtpk_s((x),0.f)<<16)
  const bf16x8 kone=(bf16x8){(short)(hi==0?0x3F80:0),0,0,0,0,0,0,0};
  bf16x8 qm=(bf16x8){0,0,0,0,0,0,0,0};
  #define SETQM() do{ const short mb_=(short)(cvtpk_s(-mhat,0.f)&0xffffu); qm[0]=(hi==0)?mb_:(short)0; }while(0)
  #define CMASK(P0,P1,t) amask<0>(P0,P1,(t),NT,0,qrel,hi)
  bool resc=false;
  #define RESC() do{ if(resc){ asm volatile("s_waitcnt lgkmcnt(0)":::"memory"); \
      _Pragma("unroll") for(int r=0;r<16;++r){ const float f_=wsf[crow(r,hi)]; o[0][r]*=f_; o[1][r]*=f_; o[2][r]*=f_; o[3][r]*=f_; } } }while(0)
  f32x16 pA0,pA1,pB0,pB1;
  int sl_prev=0,sl_cur=0,sl_next=SLOTB;
  #define ROT() do{sl_prev=sl_cur;sl_cur=sl_next;sl_next=(sl_next==(NSLOT-1)*SLOTB)?0:sl_next+SLOTB;}while(0)
  DMA_K(2,2*SLOTB);
  WAIT_BAR(4);
  { kload8(kf,kp0);
    const f32x16 z=f32x16{};
    pA0=__builtin_amdgcn_mfma_f32_32x32x16_bf16(kf[0],qr[0],z,0,0,0);pA1=__builtin_amdgcn_mfma_f32_32x32x16_bf16(kf[1],qr[0],z,0,0,0);
    pA0=__builtin_amdgcn_mfma_f32_32x32x16_bf16(kf[2],qr[1],pA0,0,0,0);pA1=__builtin_amdgcn_mfma_f32_32x32x16_bf16(kf[3],qr[1],pA1,0,0,0);
    pA0=__builtin_amdgcn_mfma_f32_32x32x16_bf16(kf[4],qr[2],pA0,0,0,0);pA1=__builtin_amdgcn_mfma_f32_32x32x16_bf16(kf[5],qr[2],pA1,0,0,0);
    pA0=__builtin_amdgcn_mfma_f32_32x32x16_bf16(kf[6],qr[3],pA0,0,0,0);pA1=__builtin_amdgcn_mfma_f32_32x32x16_bf16(kf[7],qr[3],pA1,0,0,0); }
  asm volatile("s_nop 15\n\ts_nop 7":"+v"(pA0),"+v"(pA1));CMASK(pA0,pA1,0);
  { const float rm=rowmax(pA0,pA1); mhat=BFR(rm);
    _Pragma("unroll") for(int r=0;r<16;++r){pA0[r]=__builtin_amdgcn_exp2f(pA0[r]-mhat);pA1[r]=__builtin_amdgcn_exp2f(pA1[r]-mhat);} SETQM(); }
  WAIT_BAR(0);
  DMA_K(3,0);DMA_V(1,SLOTB);
  ROT();
  kload8(kf,kp0+sl_cur);
  WAIT_BAR(3);
  s16x4 vlo[8],vhi[8]; u32x4 pw0,pw1,pw2,pw3;
  #define PKW(P,B) cvtpk_s(P[B],P[B+1])
  #define PAF(k) __builtin_bit_cast(bf16x8,pw##k)
  #define VFR(i) (bf16x8){vlo[i][0],vlo[i][1],vlo[i][2],vlo[i][3],vhi[i][0],vhi[i][1],vhi[i][2],vhi[i][3]}
  #define PIN(x) asm volatile("":"+v"(x))
  #define MX3(a,b,c) __builtin_fmaxf(__builtin_fmaxf((a),(b)),(c))
  #define GAPA(MF,A0,A1,A2,A3,W0,W1,PW) do{ MF; sacc+=A0; sacc+=A1; sacc+=A2; sacc+=A3; PIN(sacc); W0; W1; PIN(PW); SBAR(); }while(0)
  #define EX(v) __builtin_amdgcn_exp2f(v)
  #define GAPB(MF,X,B) do{ MF; X[B]=EX(X[B]); X[B+1]=EX(X[B+1]); PIN(X); SBAR(); }while(0)
  #define VRD(i) do{ vlo[i]=vtr(vp_+(((i)>>2)*4096+((i)&3)*1024)); vhi[i]=vtr(vp_+(((i)>>2)*4096+((i)&3)*1024+512)); }while(0)
  #define VRD2(i) do{ vlo[i]=vtr(vp_+(8192+((i)>>2)*4096+((i)&3)*1024)); vhi[i]=vtr(vp_+(8192+((i)>>2)*4096+((i)&3)*1024+512)); SBAR(); }while(0)
  #define KRD(G,j) do{ if(G){ kload2(kf,kp0+sl_next,j); SBAR(); } }while(0)
  #define ZC (f32x16{})
  #define STEP(C0,C1,P0,P1,t,GK,GV,GL) do{ SBAR(); \
    const lds_cptr vp_=vp0+2*sl_prev; \
    C0=__builtin_amdgcn_mfma_f32_32x32x16_bf16(kone,qm,ZC,0,0,0); C1=__builtin_amdgcn_mfma_f32_32x32x16_bf16(kone,qm,ZC,0,0,0); SBAR(); \
    VRD(0); SBAR(); float sacc=(P0[0]+P0[1]); \
    GAPA(C0=__builtin_amdgcn_mfma_f32_32x32x16_bf16(kf[0],qr[0],C0,0,0,0), P0[2],P0[3],P0[4],P0[5],     pw0[0]=PKW(P0,0), pw0[1]=PKW(P0,2), pw0); \
    VRD(4); SBAR(); GAPA(C1=__builtin_amdgcn_mfma_f32_32x32x16_bf16(kf[1],qr[0],C1,0,0,0), P0[6],P0[7],P0[8],P0[9],     pw0[2]=PKW(P0,4), pw0[3]=PKW(P0,6), pw0); \
    VRD(1); SBAR(); GAPA(C0=__builtin_amdgcn_mfma_f32_32x32x16_bf16(kf[2],qr[1],C0,0,0,0),   P0[10],P0[11],P0[12],P0[13], pw1[0]=PKW(P0,8), pw1[1]=PKW(P0,10), pw1); \
    VRD(5); SBAR(); GAPA(C1=__builtin_amdgcn_mfma_f32_32x32x16_bf16(kf[3],qr[1],C1,0,0,0),   P0[14],P0[15],P1[0],P1[1],   pw1[2]=PKW(P0,12),pw1[3]=PKW(P0,14), pw1); \
    VRD(2); SBAR(); GAPA(C0=__builtin_amdgcn_mfma_f32_32x32x16_bf16(kf[4],qr[2],C0,0,0,0),   P1[2],P1[3],P1[4],P1[5],     pw2[0]=PKW(P1,0), pw2[1]=PKW(P1,2), pw2); \
    VRD(6); SBAR(); GAPA(C1=__builtin_amdgcn_mfma_f32_32x32x16_bf16(kf[5],qr[2],C1,0,0,0),   P1[6],P1[7],P1[8],P1[9],     pw2[2]=PKW(P1,4), pw2[3]=PKW(P1,6), pw2); \
    VRD(3); SBAR(); GAPA(C0=__builtin_amdgcn_mfma_f32_32x32x16_bf16(kf[6],qr[3],C0,0,0,0),   P1[10],P1[11],P1[12],P1[13], pw3[0]=PKW(P1,8), pw3[1]=PKW(P1,10), pw3); \
    VRD(7); SBAR(); GAPA(C1=__builtin_amdgcn_mfma_f32_32x32x16_bf16(kf[7],qr[3],C1,0,0,0),   P1[14],P1[15],0.f,0.f,       pw3[2]=PKW(P1,12),pw3[3]=PKW(P1,14), pw3); \
    l_reg+=sacc; \
    if(GK){DMA_K((t)+3,sl_cur);} if(GV){DMA_V((t)+1,sl_next);} \
    CMASK(C0,C1,t); \
    { float a=MX3(C0[0],C0[1],C1[0]),b=MX3(C0[2],C0[3],C1[1]); a=MX3(a,C1[2],C1[3]); \
      _Pragma("unroll") for(int r=4;r<16;r+=4){a=MX3(a,C0[r],C0[r+1]);b=MX3(b,C0[r+2],C0[r+3]);a=MX3(a,C1[r],C1[r+1]);b=MX3(b,C1[r+2],C1[r+3]);} \
      float rm=__builtin_fmaxf(a,b); { auto rr=__builtin_amdgcn_permlane32_swap(__float_as_uint(rm),__float_as_uint(rm),false,false); rm=__builtin_fmaxf(__uint_as_float(rr[0]),__uint_as_float(rr[1])); } \
      resc=false; \
      if(__builtin_expect(__any(rm>(float)THRL),0)){ const float mn_=BFR(mhat+__builtin_fmaxf(rm,0.f)); const float dl=mn_-mhat; mhat=mn_; SETQM(); \
        _Pragma("unroll") for(int r=0;r<16;++r){C0[r]-=dl;C1[r]-=dl;} \
        const float f=__builtin_amdgcn_exp2f(-dl); l_reg*=f; if(hi==0)wsf[r32]=f; resc=true; } } \
    SBAR(); \
    GAPB(o[0]=__builtin_amdgcn_mfma_f32_32x32x16_bf16(PAF(0),VFR(0),o[0],0,0,0), C0,0);  VRD2(0); \
    GAPB(o[1]=__builtin_amdgcn_mfma_f32_32x32x16_bf16(PAF(0),VFR(4),o[1],0,0,0), C0,2);  VRD2(4); \
    GAPB(o[0]=__builtin_amdgcn_mfma_f32_32x32x16_bf16(PAF(1),VFR(1),o[0],0,0,0), C0,4);  VRD2(1); \
    GAPB(o[1]=__builtin_amdgcn_mfma_f32_32x32x16_bf16(PAF(1),VFR(5),o[1],0,0,0), C0,6);  VRD2(5); \
    GAPB(o[0]=__builtin_amdgcn_mfma_f32_32x32x16_bf16(PAF(2),VFR(2),o[0],0,0,0), C0,8);  VRD2(2); \
    GAPB(o[1]=__builtin_amdgcn_mfma_f32_32x32x16_bf16(PAF(2),VFR(6),o[1],0,0,0), C0,10); VRD2(6); \
    GAPB(o[0]=__builtin_amdgcn_mfma_f32_32x32x16_bf16(PAF(3),VFR(3),o[0],0,0,0), C0,12); VRD2(3); \
    GAPB(o[1]=__builtin_amdgcn_mfma_f32_32x32x16_bf16(PAF(3),VFR(7),o[1],0,0,0), C0,14); VRD2(7); \
    GAPB(o[2]=__builtin_amdgcn_mfma_f32_32x32x16_bf16(PAF(0),VFR(0),o[2],0,0,0), C1,0); \
    GAPB(o[3]=__builtin_amdgcn_mfma_f32_32x32x16_bf16(PAF(0),VFR(4),o[3],0,0,0), C1,2); \
    KRD(GL,0); GAPB(o[2]=__builtin_amdgcn_mfma_f32_32x32x16_bf16(PAF(1),VFR(1),o[2],0,0,0), C1,4); \
    KRD(GL,1); GAPB(o[3]=__builtin_amdgcn_mfma_f32_32x32x16_bf16(PAF(1),VFR(5),o[3],0,0,0), C1,6); \
    KRD(GL,2); GAPB(o[2]=__builtin_amdgcn_mfma_f32_32x32x16_bf16(PAF(2),VFR(2),o[2],0,0,0), C1,8); \
    KRD(GL,3); GAPB(o[3]=__builtin_amdgcn_mfma_f32_32x32x16_bf16(PAF(2),VFR(6),o[3],0,0,0), C1,10); \
    GAPB(o[2]=__builtin_amdgcn_mfma_f32_32x32x16_bf16(PAF(3),VFR(3),o[2],0,0,0), C1,12); \
    GAPB(o[3]=__builtin_amdgcn_mfma_f32_32x32x16_bf16(PAF(3),VFR(7),o[3],0,0,0), C1,14); \
    }while(0)
  int t=1;
  #undef CMASK
  #define CMASK(P0,P1,t) do{}while(0)
  for(;t+5<NT;t+=2){
    STEP(pB0,pB1,pA0,pA1,t,true,true,true);     WAIT_BAR(3); RESC(); ROT();
    STEP(pA0,pA1,pB0,pB1,t+1,true,true,true);   WAIT_BAR(3); RESC(); ROT();
  }
  #undef CMASK
  #define CMASK(P0,P1,t) amask<0>(P0,P1,(t),NT,0,qrel,hi)
  #define ENDW(tt) do{ if((tt)+3<NT){WAIT_BAR(3);} else if((tt)+2<NT){WAIT_BAR(2);} else {WAIT_BAR(0);} }while(0)
  for(;t+1<NT;t+=2){
    STEP(pB0,pB1,pA0,pA1,t,(t+3<NT),(t+1<NT),(t+1<NT));       ENDW(t);   RESC(); ROT();
    STEP(pA0,pA1,pB0,pB1,t+1,(t+4<NT),(t+2<NT),(t+2<NT));     ENDW(t+1); RESC(); ROT();
  }
  STEP(pB0,pB1,pA0,pA1,NT-1,false,false,false); RESC();
  { float sacc=pB0[0]+pB0[1]; _Pragma("unroll") for(int r=2;r<16;++r)sacc+=pB0[r]; _Pragma("unroll") for(int r=0;r<16;++r)sacc+=pB1[r]; l_reg+=sacc;
    pw0=(u32x4){PKW(pB0,0),PKW(pB0,2),PKW(pB0,4),PKW(pB0,6)};pw1=(u32x4){PKW(pB0,8),PKW(pB0,10),PKW(pB0,12),PKW(pB0,14)};pw2=(u32x4){PKW(pB1,0),PKW(pB1,2),PKW(pB1,4),PKW(pB1,6)};pw3=(u32x4){PKW(pB1,8),PKW(pB1,10),PKW(pB1,12),PKW(pB1,14)};
    SBAR(); pv(o,vb0+2*sl_cur,PAF(0),PAF(1),PAF(2),PAF(3)); SBAR(); pv(o+2,vb0+2*sl_cur+8192,PAF(0),PAF(1),PAF(2),PAF(3)); }
  #undef PKW
  #undef PAF
  #undef VFR
  #undef PIN
  #undef MX3
  #undef GAPA
  #undef GAPB
  #undef EX
  #undef VRD
  #undef VRD2
  #undef KRD
  #undef ZC
  #undef BFR
  #undef SETQM
  #undef STEP
  #undef ENDW
  {auto rr=__builtin_amdgcn_permlane32_swap(__float_as_uint(l_reg),__float_as_uint(l_reg),false,false);l_reg=__uint_as_float(rr[0])+__uint_as_float(rr[1]);}
  if(hi==0){wsf[32+r32]=l_reg;}asm volatile("s_waitcnt lgkmcnt(0)":::"memory");
  float rli[16];
  #pragma unroll
  for(int r=0;r<16;++r)rli[r]=__builtin_amdgcn_rcpf(wsf[32+crow(r,hi)]);
  bf16*Ow=O0+(wid*QBLK)*ostride;
  { bf16*stg=(bf16*)(shm+LDS2_OST)+wid*2048;
    #pragma unroll
    for(int j=0;j<2;++j){
      #pragma unroll
      for(int r=0;r<16;++r){const int orow=crow(r,hi);
        #pragma unroll
        for(int d0=0;d0<2;++d0)stg[orow*64+d0*32+r32]=__float2bfloat16(o[2*j+d0][r]*rli[r]);}
      asm volatile("s_waitcnt lgkmcnt(0)":::"memory");
      #pragma unroll
      for(int i=0;i<4;++i){const int row=i*8+(lane>>3),ch=lane&7; const u32x4 v=*(const u32x4*)(stg+row*64+ch*8); ATTN_STORE16(Ow+row*ostride+j*64+ch*8,v);}
      asm volatile("s_waitcnt lgkmcnt(0)":::"memory"); } }
  asm volatile("s_waitcnt lgkmcnt(0)\n\ts_barrier":::"memory");
  #undef DMA_K
  #undef DMA_V
  #undef CMASK
  #undef RESC
  #undef ROT
}
constexpr int DS_K=0, DS_V=6*8192, DS_WS=12*8192, DS_OST=DS_WS+NW*64*4, DS_BYTES=DS_OST+NW*4096;
struct DswaUnit { const bf16* Q0; const bf16* K0; const bf16* V0; bf16* O0; float* ls; int d; int kmin; int chain; };
__device__ __forceinline__ DswaUnit dswa_desc(int u,const bf16*U,bf16*OA,float*LSE){
  constexpr int UPc=3072, SEQc=8192, Mc=16384;
  const int g=u>>9, rem=u&511, b=rem>>8, h=(rem>>5)&7, w=rem&31;
  const int d=g==0?1:(g==1?4:16), nqb=32/d, r=w/nqb, qb=w%nqb, l0=256*qb;
  const long rb=(long)b*SEQc, pos0=(long)l0*d+r, kpos0=(long)(l0-128)*d+r;
  DswaUnit x; x.Q0=U+(rb+pos0)*UPc+h*64; x.K0=U+(rb+kpos0)*UPc+512+h*64; x.V0=U+(rb+kpos0)*UPc+1024+h*64;
  x.O0=OA+(long)g*Mc*512+(rb+pos0)*512+h*64; x.ls=LSE+(long)g*Mc*8+(rb+pos0)*8+h; x.d=d; x.kmin=qb==0?128:0; x.chain=(rem<511&&qb+1<nqb)?1:0; return x;
}
__device__ __forceinline__ void wait_vm(int n){
  switch(n){ case 0: asm volatile("s_waitcnt vmcnt(0)":::"memory"); break; case 2: asm volatile("s_waitcnt vmcnt(2)":::"memory"); break; case 4: asm volatile("s_waitcnt vmcnt(4)":::"memory"); break;
    case 6: asm volatile("s_waitcnt vmcnt(6)":::"memory"); break; case 8: asm volatile("s_waitcnt vmcnt(8)":::"memory"); break; default: asm volatile("s_waitcnt vmcnt(10)":::"memory"); break; }
}
template<int THRL> __device__ __forceinline__ void dswa_phase(const bf16*U,bf16*OA,float*LSE,const int ubase,const int nunits,char*shm){
  constexpr int UPc=3072;
  int tid=threadIdx.x; asm volatile("":"+v"(tid)); const int lane=tid&63,r32=lane&31,hi=lane>>5; const int wid=__builtin_amdgcn_readfirstlane(tid>>6);
  const unsigned lds0=(unsigned)(uintptr_t)shm;
  float*wsf=(float*)(shm+DS_WS)+wid*64;
  const unsigned kvo1=(unsigned)(lane*UPc)*2u, vvo1=(unsigned)((16*(wid&3)+(lane>>2))*UPc)*2u, kvoc=(unsigned)(wid*8)*2u, vvoc=(unsigned)((wid>>2)*32+(lane&3)*8)*2u;
  const unsigned kdst=lds0+DS_K+wid*1024, vdst=lds0+DS_V+wid*1024;
  const lds_cptr shm3=(lds_cptr)shm; const lds_cptr kp0=shm3+DS_K+hi*1024+r32*16;
  const int vb0=(int)(lds0+DS_V)+((lane>>4)&1)*32+(lane&3)*8+(4*hi+((lane&15)>>2))*64;
  const int qrel=wid*QBLK+r32;
  #define DS_ISSUE(X,t,sl) do{ const int ks_=64*(t)*UPc*(X).d; \
    glds16((X).K0+ks_,kvo1*(unsigned)(X).d+kvoc,(unsigned)__builtin_amdgcn_readfirstlane(kdst+(sl)*8192)); \
    glds16((X).V0+ks_,vvo1*(unsigned)(X).d+vvoc,(unsigned)__builtin_amdgcn_readfirstlane(vdst+(sl)*8192)); }while(0)
  #define SLOT(map,t) (((map)>>(4*(t)))&7)
  #define DS_LOADQ(X) do{ const bf16*Qw_=(X).Q0+(wid*QBLK+r32)*(UPc*(X).d); _Pragma("unroll") for(int d0=0;d0<4;++d0)qr[d0]=*reinterpret_cast<const bf16x8*>(Qw_+d0*16+hi*8); }while(0)
  #define PKW(P,B) cvtpk_s(P[B],P[B+1])
  #define PAF(k) __builtin_bit_cast(bf16x8,pw##k)
  DswaUnit cur=dswa_desc(ubase,U,OA,LSE);
  bf16x8 qr[4]; bf16x8 kf[8]; u32x4 pw0,pw1,pw2,pw3; f32x16 p0,p1;
  #pragma unroll
  for(int t=0;t<6;++t)DS_ISSUE(cur,t,t);
  unsigned smap=0x543210u;
  DS_LOADQ(cur);
  for(int ui=0;ui<nunits;++ui){
    const bool has_next=ui+1<nunits;
    DswaUnit nxt=cur; if(has_next)nxt=dswa_desc(ubase+ui+1,U,OA,LSE);
    const bool chain=has_next&&cur.chain!=0; const int nt0=chain?2:0;
    const unsigned nmap=chain?(((smap>>16)&0xffu)|((smap&0xffffu)<<8)):smap;
    const int t_a=wid>>1, t_min=cur.kmin>>6, t_lo=t_a<t_min?t_min:t_a;
    const int mlo=cur.kmin-qrel, lo_=mlo<0?0:mlo;
    float mhat=0.f,l_reg=0.f; f32x16 o[2]; o[0]=f32x16{}; o[1]=f32x16{}; f32x16 negm=f32x16{}; asm volatile("":"+v"(negm));
    #pragma unroll 1
    for(int j=0;j<3;++j){
      const int s=t_a+j;
      wait_vm(j==0?4:((j==1||has_next)?2:0));
      asm volatile("s_waitcnt lgkmcnt(0)\n\ts_barrier":::"memory");
      if(has_next&&j>0)DS_ISSUE(nxt,nt0+j-1,SLOT(smap,j-1));
      if(s>=t_lo){
        kload8(kf,kp0+SLOT(smap,s)*8192);
        p0=__builtin_amdgcn_mfma_f32_32x32x16_bf16(kf[0],qr[0],negm,0,0,0);p1=__builtin_amdgcn_mfma_f32_32x32x16_bf16(kf[1],qr[0],negm,0,0,0);
        p0=__builtin_amdgcn_mfma_f32_32x32x16_bf16(kf[2],qr[1],p0,0,0,0);p1=__builtin_amdgcn_mfma_f32_32x32x16_bf16(kf[3],qr[1],p1,0,0,0);
        p0=__builtin_amdgcn_mfma_f32_32x32x16_bf16(kf[4],qr[2],p0,0,0,0);p1=__builtin_amdgcn_mfma_f32_32x32x16_bf16(kf[5],qr[2],p1,0,0,0);
        p0=__builtin_amdgcn_mfma_f32_32x32x16_bf16(kf[6],qr[3],p0,0,0,0);p1=__builtin_amdgcn_mfma_f32_32x32x16_bf16(kf[7],qr[3],p1,0,0,0);
        asm volatile("s_nop 15\n\ts_nop 7":"+v"(p0),"+v"(p1));
        if(j!=1||cur.kmin!=0){ const int kb=64*s+4*hi-qrel-lo_; const unsigned span=(unsigned)(128-lo_);
          #pragma unroll
          for(int r=0;r<16;++r){ const int dv=kb+(r&3)+8*(r>>2); if((unsigned)dv>span)p0[r]=-INFINITY; if((unsigned)(dv+32)>span)p1[r]=-INFINITY; } }
        const float rm=rowmax(p0,p1); bool resc=false;
        if(s==t_lo){ const float dl=(rm<-1e30f)?0.f:rm; mhat+=dl;
          #pragma unroll
          for(int r=0;r<16;++r){p0[r]-=dl;p1[r]-=dl;}
          #pragma unroll
          for(int r=0;r<16;++r)negm[r]=-mhat;
          asm volatile("":"+v"(negm)); }
        else if(__any(rm>(float)THRL)){ const float dl=__builtin_fmaxf(rm,0.f); mhat+=dl;
          #pragma unroll
          for(int r=0;r<16;++r){p0[r]-=dl;p1[r]-=dl;}
          #pragma unroll
          for(int r=0;r<16;++r)negm[r]=-mhat;
          asm volatile("":"+v"(negm));
          const float f=__builtin_amdgcn_exp2f(-dl); l_reg*=f; if(hi==0)wsf[r32]=f; resc=true; }
        #pragma unroll
        for(int r=0;r<16;++r){p0[r]=__builtin_amdgcn_exp2f(p0[r]);p1[r]=__builtin_amdgcn_exp2f(p1[r]);}
        if(resc){ asm volatile("s_waitcnt lgkmcnt(0)":::"memory");
          #pragma unroll
          for(int r=0;r<16;++r){ const float f_=wsf[crow(r,hi)]; o[0][r]*=f_; o[1][r]*=f_; } }
        { float sacc=p0[0]+p0[1];
          #pragma unroll
          for(int r=2;r<16;++r)sacc+=p0[r];
          #pragma unroll
          for(int r=0;r<16;++r)sacc+=p1[r];
          l_reg+=sacc; }
        pw0=(u32x4){PKW(p0,0),PKW(p0,2),PKW(p0,4),PKW(p0,6)};pw1=(u32x4){PKW(p0,8),PKW(p0,10),PKW(p0,12),PKW(p0,14)};pw2=(u32x4){PKW(p1,0),PKW(p1,2),PKW(p1,4),PKW(p1,6)};pw3=(u32x4){PKW(p1,8),PKW(p1,10),PKW(p1,12),PKW(p1,14)};
        pv(o,vb0+SLOT(smap,s)*8192,PAF(0),PAF(1),PAF(2),PAF(3));
      }
    }
    const DswaUnit fin=cur;
    asm volatile("s_waitcnt lgkmcnt(0)\n\ts_barrier":::"memory");
    if(has_next)DS_LOADQ(nxt);
    {auto rr=__builtin_amdgcn_permlane32_swap(__float_as_uint(l_reg),__float_as_uint(l_reg),false,false);l_reg=__uint_as_float(rr[0])+__uint_as_float(rr[1]);}
    if(hi==0){wsf[32+r32]=l_reg; fin.ls[(wid*QBLK+r32)*(8*fin.d)]=mhat+__builtin_amdgcn_logf(l_reg);}asm volatile("s_waitcnt lgkmcnt(0)":::"memory");
    float rli[16];
    #pragma unroll
    for(int r=0;r<16;++r)rli[r]=__builtin_amdgcn_rcpf(wsf[32+crow(r,hi)]);
    { bf16*Ow=fin.O0+(wid*QBLK)*(512*fin.d); bf16*stg=(bf16*)(shm+DS_OST)+wid*2048;
      #pragma unroll
      for(int r=0;r<16;++r){const int orow=crow(r,hi);
        #pragma unroll
        for(int d0=0;d0<2;++d0)stg[orow*64+d0*32+r32]=__float2bfloat16(o[d0][r]*rli[r]);}
      asm volatile("s_waitcnt lgkmcnt(0)":::"memory");
      #pragma unroll
      for(int i=0;i<4;++i){const int row=i*8+(lane>>3),ch=lane&7; const u32x4 v=*(const u32x4*)(stg+row*64+ch*8); *(u32x4*)(Ow+row*(512*fin.d)+ch*8)=v;} }
    asm volatile("":::"memory");
    if(has_next){ if(chain){ DS_ISSUE(nxt,4,SLOT(smap,2)); DS_ISSUE(nxt,5,SLOT(smap,3)); } else { DS_ISSUE(nxt,2,SLOT(smap,2)); DS_ISSUE(nxt,3,SLOT(smap,3)); DS_ISSUE(nxt,4,SLOT(smap,4)); DS_ISSUE(nxt,5,SLOT(smap,5)); } }
    cur=nxt; smap=nmap;
  }
  asm volatile("s_waitcnt vmcnt(0)":::"memory");
  #undef DS_ISSUE
  #undef SLOT
  #undef DS_LOADQ
  #undef PKW
  #undef PAF
}
constexpr int ATTN_LDS_BYTES=LDS2_BYTES;
#undef SBAR
#undef WAIT_BAR
}
namespace cg = cooperative_groups;
constexpr int NWAVES = 8;
#ifndef MK_N_LAUNCHES
#define MK_N_LAUNCHES 1
#endif
constexpr int NPHASE = 11;
constexpr int SEQ = 8192, DM = 1024, M = 16384, INC = 4096, PLE = 256, UP = 3072;
constexpr size_t MiB = 1u << 20;
constexpr size_t WS_ROPE = 1 * MiB, WS_SSQA = WS_ROPE + 512 * 1024, WS_LSE = WS_SSQA + 1 * MiB;
constexpr size_t WS_WIN = 4 * MiB, WS_WOUT = 20 * MiB, WS_WGATE = 24 * MiB, WS_WPLE = 28 * MiB, WS_SSQB = 29 * MiB;
constexpr size_t WS_PB = 30 * MiB, WS_HB2 = 46 * MiB, WS_GATE = 78 * MiB, WS_OA = 110 * MiB, WS_U = 158 * MiB, WS_END = 254 * MiB;
constexpr size_t WS_OD = WS_HB2, WS_E = WS_U, WS_HB1 = WS_U + 32 * MiB;
static_assert(WS_LSE + 3 * (size_t)M * 8 * 4 <= WS_WIN && WS_U + (size_t)M * UP * 2 == WS_END, "d_ws map");
constexpr int LDS_BYTES = 155648;
#ifndef REP_PRO
#define REP_PRO 1
#endif
#ifndef REP_G1
#define REP_G1 1
#endif
#ifndef REP_DIFF
#define REP_DIFF 1
#endif
#ifndef REP_DSWA
#define REP_DSWA 1
#endif
#ifndef REP_G2
#define REP_G2 1
#endif
#ifndef REP_G3D
#define REP_G3D 0
#endif
#ifndef REP_E
#define REP_E 1
#endif

#define GAS __attribute__((address_space(1)))
#define LAS __attribute__((address_space(3)))
typedef unsigned short bf16;
typedef unsigned v4u __attribute__((ext_vector_type(4)));
typedef float f32x4 __attribute__((ext_vector_type(4)));
#define LDS_WAIT() asm volatile("s_waitcnt lgkmcnt(0)" ::: "memory")
__device__ __forceinline__ unsigned f2bf(float f) { unsigned u = __builtin_bit_cast(unsigned, f); return (u + 0x7fffu + ((u >> 16) & 1u)) >> 16; }
__device__ __forceinline__ unsigned pk2(float lo, float hi) { return f2bf(lo) | (f2bf(hi) << 16); }
__device__ __forceinline__ float bflo(unsigned u) { return __uint_as_float(u << 16); }
__device__ __forceinline__ float bfhi(unsigned u) { return __uint_as_float(u & 0xffff0000u); }
__device__ __forceinline__ float wave_sum(float v) {
#pragma unroll
    for (int o = 1; o < 64; o <<= 1) v += __shfl_xor(v, o);
    return v;
}
typedef GAS unsigned gu32;
#define RLX_AGENT __ATOMIC_RELAXED, __HIP_MEMORY_SCOPE_AGENT
constexpr int RSL_OFF = 133120, ROPEL_OFF = RSL_OFF + 1024, MISC_OFF = ROPEL_OFF + 16384;
constexpr size_t WS_CTL = 0, CTL_ZERO_BYTES = 65536;
#define XB_TMO      128
#define XB_XCNT(j)  (256  + 64 * (j))
#define XB_XSUB(j)  (1280 + 64 * (j))
#define XB_XGEN(j)  (2304 + 64 * (j))
#define XB_TOP      3328
#define XB_TOPGEN   3392
#define XCD_BAR_WORDS 3456
#define XB_SPIN_CAP (1u << 18)

__device__ __forceinline__ unsigned xb_ld(unsigned* p)              { return __hip_atomic_load(p, __ATOMIC_RELAXED, __HIP_MEMORY_SCOPE_AGENT); }
__device__ __forceinline__ unsigned xb_add(unsigned* p, unsigned v) { return __hip_atomic_fetch_add(p, v, __ATOMIC_RELAXED, __HIP_MEMORY_SCOPE_AGENT); }
__device__ __forceinline__ unsigned xb_xcc_id() { return (unsigned)__builtin_amdgcn_s_getreg((3 << 11) | 20) & 0xFu; }
#define XB_SPIN(cond, bar) do { unsigned _sp = 0; while (cond) { __builtin_amdgcn_s_sleep(1); \
    if ((++_sp & 255u) == 0u) { if (xb_ld(&(bar)[XB_TMO])) break; if (_sp > XB_SPIN_CAP) { atomicAdd(&(bar)[XB_TMO], 1u); break; } } } } while (0)

struct XcdBarrier {
    unsigned* bar; unsigned x;
    volatile LAS unsigned* st;
};

__device__ __forceinline__ XcdBarrier xcd_barrier_post(unsigned* bar, volatile LAS unsigned* st) {
    XcdBarrier b; b.bar = bar; b.x = xb_xcc_id(); b.st = st;
    if (threadIdx.x == 0) (void)xb_add(&bar[XB_XCNT(b.x)], 1u);
    return b;
}
__device__ __forceinline__ void xcd_barrier_complete(unsigned* bar, unsigned x, unsigned& nloc, unsigned& nx) {
    const unsigned G = gridDim.x * gridDim.y * gridDim.z;
    unsigned sum, cnt, mine, sp = 0u;
    for (;;) {
        sum = 0u; cnt = 0u; mine = 0u;
#pragma unroll
        for (unsigned j = 0; j < 16; ++j) { const unsigned c = xb_ld(&bar[XB_XCNT(j)]); sum += c; cnt += (c > 0u) ? 1u : 0u; mine = (j == x) ? c : mine; }
        if (sum == G) break;
        __builtin_amdgcn_s_sleep(1);
        if ((++sp & 255u) == 0u) { if (xb_ld(&bar[XB_TMO])) break; if (sp > XB_SPIN_CAP) { atomicAdd(&bar[XB_TMO], 1u); break; } }
    }
    nloc = mine > 0u ? mine : 1u; nx = cnt > 0u ? cnt : 1u;
}

__device__ __forceinline__ void xcd_barrier(const XcdBarrier& b) {
    asm volatile("s_waitcnt vmcnt(0)" ::: "memory");
    __syncthreads();
    if (threadIdx.x == 0) {
        unsigned* bar = b.bar;
        __builtin_amdgcn_s_waitcnt(0);
        unsigned nloc = b.st[0], nx = b.st[1];
        if (nloc == 0u) { xcd_barrier_complete(bar, b.x, nloc, nx); b.st[0] = nloc; b.st[1] = nx; }
        const unsigned old = xb_add(&bar[XB_XSUB(b.x)], 1u);
        const unsigned gen = old / nloc;
        if (old + 1u == (gen + 1u) * nloc) {
            __builtin_amdgcn_fence(__ATOMIC_RELEASE, "agent");
            asm volatile("s_waitcnt vmcnt(0)" ::: "memory");
            const unsigned og = xb_add(&bar[XB_TOP], 1u);
            const unsigned tg = og / nx;
            if (og + 1u == (tg + 1u) * nx) xb_add(&bar[XB_TOPGEN], 1u);
            else XB_SPIN(xb_ld(&bar[XB_TOPGEN]) == tg, bar);
            __builtin_amdgcn_fence(__ATOMIC_ACQUIRE, "agent");
            xb_add(&bar[XB_XGEN(b.x)], 1u);
            asm volatile("s_waitcnt vmcnt(0)" ::: "memory");
        } else {
            XB_SPIN(xb_ld(&bar[XB_XGEN(b.x)]) == gen, bar);
            __builtin_amdgcn_fence(__ATOMIC_ACQUIRE, "agent");
            asm volatile("s_waitcnt vmcnt(0)" ::: "memory");
        }
    }
    __syncthreads();
}

__device__ __forceinline__ void p0_transpose_item(const float* W, const float* gain, int K, int N, bf16* WT, LAS float* scr, int item, int lane, bool ropeperm = false) {
    const int nblk = N / 64, kb = item / nblk, nb = item % nblk, k0 = 32 * kb, n0 = 64 * nb;
    f32x4 v[8];
#pragma unroll
    for (int i = 0; i < 8; ++i) { const int kk = 4 * i + (lane >> 4); v[i] = *(const f32x4*)(W + (size_t)(k0 + kk) * N + n0 + (lane & 15) * 4); }
#pragma unroll
    for (int i = 0; i < 8; ++i) { const int kk = 4 * i + (lane >> 4); const float g = gain ? gain[k0 + kk] : 1.0f; LAS float* d = scr + kk * 65 + (lane & 15) * 4;
        d[0] = g * v[i][0]; d[1] = g * v[i][1]; d[2] = g * v[i][2]; d[3] = g * v[i][3]; }
    LDS_WAIT(); asm volatile("" ::: "memory");
    const int c = lane & 3;
#pragma unroll
    for (int j = 0; j < 4; ++j) { const int n = (lane >> 2) + 16 * j; const LAS float* s = scr + (8 * c) * 65 + n;
        v4u o; o.x = pk2(s[0 * 65], s[1 * 65]); o.y = pk2(s[2 * 65], s[3 * 65]); o.z = pk2(s[4 * 65], s[5 * 65]); o.w = pk2(s[6 * 65], s[7 * 65]);
        const int np = (ropeperm && n < 16) ? ((n < 8) ? 2 * n : 2 * (n - 8) + 1) : n;
        *(GAS v4u*)(WT + (size_t)(n0 + np) * K + k0 + 8 * c) = o; }
    LDS_WAIT(); asm volatile("" ::: "memory");
}

struct BalancedOrder : pg8::StaticOrder {
    __device__ bool next(int i, pg8::Unit& u) const { const bool r = pg8::StaticOrder::next(i, u); if (r && u.pn >= 4 && u.pn < 12) u.pn ^= 2; return r; }
};
struct Args { const float* in[14]; float* out; unsigned char* ws; int ph_lo, ph_hi; };
static_assert(sizeof(Args) == 14 * 8 + 8 + 8 + 8, "Args has no padding");

__global__ void __launch_bounds__(NWAVES * 64, 2) hymba_fwd(Args args) {
    extern __shared__ __attribute__((aligned(16))) unsigned char lds[];
    typedef const __attribute__((address_space(4))) Args* kargp_t;
    kargp_t KA = (kargp_t)__builtin_amdgcn_kernarg_segment_ptr();
#define PTRS() asm volatile("" : "+s"(KA)); unsigned char* ws = KA->ws; \
    int tid = threadIdx.x; asm volatile("" : "+v"(tid)); const int lane = tid & 63, wave = __builtin_amdgcn_readfirstlane(tid >> 6); \
    const int G = gridDim.x; const int bx = blockIdx.x; const int vcu = (G % 8 == 0) ? (bx % 8) * (G / 8) + bx / 8 : bx; const int gw = vcu * NWAVES + wave, NGW = G * NWAVES; (void)lane; (void)gw; (void)NGW; \
    const float* x = KA->in[0]; const float* p = KA->in[1]; const float* attn_g = KA->in[2]; const float* w_in = KA->in[3]; const float* w_out = KA->in[4]; \
    const float* lq1 = KA->in[5]; const float* lk1 = KA->in[6]; const float* lq2 = KA->in[7]; const float* lk2 = KA->in[8]; const float* subln_g = KA->in[9]; \
    const float* ple_g = KA->in[10]; const float* w_gate = KA->in[11]; const float* w_ple = KA->in[12]; const float* final_g = KA->in[13]; \
    float* H = KA->out; \
    float* ROPE = (float*)(ws + WS_ROPE); float* SSQA = (float*)(ws + WS_SSQA); float* SSQB = (float*)(ws + WS_SSQB); float* LSE = (float*)(ws + WS_LSE); \
    bf16* WIN = (bf16*)(ws + WS_WIN); bf16* WOUT = (bf16*)(ws + WS_WOUT); bf16* WGATE = (bf16*)(ws + WS_WGATE); bf16* WPLE = (bf16*)(ws + WS_WPLE); \
    bf16* PB = (bf16*)(ws + WS_PB); bf16* HB2 = (bf16*)(ws + WS_HB2); bf16* HB1 = (bf16*)(ws + WS_HB1); bf16* GATE = (bf16*)(ws + WS_GATE); \
    bf16* OA = (bf16*)(ws + WS_OA); bf16* OD = (bf16*)H;     bf16* U = (bf16*)(ws + WS_U); bf16* EB = (bf16*)(ws + WS_E); \
    (void)x; (void)p; (void)attn_g; (void)w_in; (void)w_out; (void)lq1; (void)lk1; (void)lq2; (void)lk2; (void)subln_g; (void)ple_g; (void)w_gate; (void)w_ple; (void)final_g; (void)H; \
    (void)ROPE; (void)SSQA; (void)SSQB; (void)LSE; (void)WIN; (void)WOUT; (void)WGATE; (void)WPLE; (void)PB; (void)HB2; (void)HB1; (void)GATE; (void)OA; (void)OD; (void)U; (void)EB
    const int lo = KA->ph_lo, hi = KA->ph_hi;
    { volatile LAS unsigned* M0 = (volatile LAS unsigned*)((LAS unsigned char*)lds + MISC_OFF); if (threadIdx.x < 32) M0[threadIdx.x] = 0u; }
    __syncthreads();
    XcdBarrier bar = xcd_barrier_post((unsigned*)(KA->ws + WS_CTL) + 1024, (volatile LAS unsigned*)((LAS unsigned char*)lds + MISC_OFF) + 8);
#define IN(k) (lo <= (k) && (k) < hi)
#define SEAM(k) do { if (IN(k) && IN((k) + 1)) xcd_barrier(bar); } while (0)

    if (IN(0)) for (int rep = 0; rep < REP_PRO; ++rep) { PTRS();
        LAS float* scr = (LAS float*)((LAS unsigned char*)lds + wave * 16384);
        constexpr int I_IN = (DM / 32) * (INC / 64), I_SQ = (DM / 32) * (DM / 64), I_PL = (PLE / 32) * (DM / 64), I_L = I_IN + 2 * I_SQ + I_PL;
        for (int it = gw; it < 2 * I_L; it += NGW) {
            const int l = it / I_L; int r = it % I_L;
            if (r < I_IN) { const int n0_ = 64 * (r % (INC / 64)); p0_transpose_item(w_in + (size_t)l * DM * INC, attn_g + l * DM, DM, INC, WIN + (size_t)l * DM * INC, scr, r, lane, (n0_ & 2047) < 1024); continue; } r -= I_IN;
            if (r < I_SQ) { p0_transpose_item(w_out + (size_t)l * DM * DM, nullptr, DM, DM, WOUT + (size_t)l * DM * DM, scr, r, lane); continue; } r -= I_SQ;
            if (r < I_SQ) { p0_transpose_item(w_gate + (size_t)l * DM * DM, ple_g + l * DM, DM, DM, WGATE + (size_t)l * DM * DM, scr, r, lane); continue; } r -= I_SQ;
            p0_transpose_item(w_ple + (size_t)l * PLE * DM, nullptr, PLE, DM, WPLE + (size_t)l * PLE * DM, scr, r, lane);
        }
        for (int m0 = gw; m0 < M; m0 += 4 * NGW) {
            f32x4 v[4][4];
#pragma unroll
            for (int q = 0; q < 4; ++q) { const int m = m0 + q * NGW; const f32x4* xr = (const f32x4*)(x + (size_t)(m < M ? m : m0) * DM) + lane;
#pragma unroll
                for (int j = 0; j < 4; ++j) v[q][j] = xr[64 * j]; }
#pragma unroll
            for (int q = 0; q < 4; ++q) { const int m = m0 + q * NGW; if (m < M) {
                unsigned long long* o8 = (unsigned long long*)(HB2 + (size_t)m * DM) + lane; float s = 0.f;
#pragma unroll
                for (int j = 0; j < 4; ++j) { const f32x4 w = v[q][j]; s += (w[0] * w[0] + w[1] * w[1]) + (w[2] * w[2] + w[3] * w[3]); o8[64 * j] = (unsigned long long)pk2(w[0], w[1]) | ((unsigned long long)pk2(w[2], w[3]) << 32); }
                s = wave_sum(s);
                if (lane < 16) SSQA[(size_t)m * 16 + lane] = lane == 0 ? s : 0.f; } }
        }
        { const size_t NI = (size_t)2 * M * PLE / 8, ST = (size_t)NGW * 64;
          for (size_t i0 = (size_t)gw * 64 + lane; i0 < NI; i0 += 4 * ST) {
            f32x4 a[4], b[4];
#pragma unroll
            for (int q = 0; q < 4; ++q) { const size_t i = i0 + q * ST < NI ? i0 + q * ST : i0; a[q] = ((const f32x4*)p)[2 * i]; b[q] = ((const f32x4*)p)[2 * i + 1]; }
#pragma unroll
            for (int q = 0; q < 4; ++q) { const size_t i = i0 + q * ST; if (i < NI) { v4u o; o.x = pk2(a[q][0], a[q][1]); o.y = pk2(a[q][2], a[q][3]); o.z = pk2(b[q][0], b[q][1]); o.w = pk2(b[q][2], b[q][3]); ((v4u*)PB)[i] = o; } }
          } }
        for (int i = gw * 64 + lane; i < SEQ * 8; i += NGW * 64) {
            const int pos = i >> 3, c = i & 7;
            const float inv = c == 0 ? 1.0f : c == 1 ? 0.19392274474868576f : c == 2 ? 0.03760603093086393f : c == 3 ? 0.007292664737217109f : c == 4 ? 0.001414213562373095f : c == 5 ? 0.0002742481756762073f : c == 6 ? 5.318295896944988e-05f : 1.031338537721246e-05f;
            const float ang = (float)pos * inv;
            const double rev = (double)ang * 0.15915494309189535; const float fr = (float)(rev - __builtin_rint(rev));
            ROPE[pos * 16 + c] = __builtin_amdgcn_cosf(fr); ROPE[pos * 16 + 8 + c] = __builtin_amdgcn_sinf(fr);
        }
    }
    SEAM(0);

auto layer = [&](auto LC) __attribute__((always_inline)) {
        constexpr int l = decltype(LC)::value;
        constexpr int P = 1 + 5 * l;
        if (IN(P)) for (int rep = 0; rep < REP_G1; ++rep) { PTRS();
            pg8::Gemm g{HB2, WIN + (size_t)l * DM * INC, M, INC, DM}; BalancedOrder S; S.init(M, INC, G, bx);
            LAS float* rsl = (LAS float*)((LAS unsigned char*)lds + RSL_OFF);
            { pg8::Unit u0; S.next(0, u0); pg8::Unit u3; const bool same = !S.next(3, u3) || u3.pm == u0.pm; (void)same;
              if (tid < 256) rsl[tid] = pg8::rstd_of(SSQA + (size_t)(u0.pm * 256 + tid) * 16);
              { const int rr = tid & 255, hf = tid >> 8; const f32x4* src = (const f32x4*)(ROPE + (size_t)((u0.pm * 256 + rr) & 8191) * 16 + hf * 8); LAS f32x4* dst = (LAS f32x4*)((LAS unsigned char*)lds + ROPEL_OFF) + rr * 4 + hf * 2; dst[0] = src[0]; dst[1] = src[1]; }
              __syncthreads(); }
            pg8::EpiQKVG E{U, GATE, rsl, (LAS float*)((LAS unsigned char*)lds + ROPEL_OFF)};
            pg8::gemm_phase<pg8::EpiQKVG, BalancedOrder, PG8_ALIGN, PG8_SP2>((LAS unsigned char*)lds, g, S, E);
        }
        SEAM(P);
        if (IN(P + 1)) { PTRS();
            using abf = attn_body::bf16;
            for (int rep = 0; rep < REP_DIFF; ++rep) { const int bhc = vcu >> 4, s = vcu & 15, c = bhc & 1, h = (bhc >> 1) & 3, b = bhc >> 3;
              for (int i = 0; i < 2; ++i) { const int qb = (i == 0) ? s : 31 - s; const size_t rb = (size_t)b * SEQ, q0 = (size_t)qb * 256;
                  const abf* Q0 = (const abf*)U + (rb + q0) * UP + 1536 + h * 128 + c * 64; const abf* K0 = (const abf*)U + rb * UP + 2048 + h * 128 + c * 64; const abf* V0 = (const abf*)U + rb * UP + 2560 + h * 128;
                  abf* O0 = (abf*)OD + (size_t)c * M * 512 + (rb + q0) * 512 + h * 128;
                  attn_body::attn_unit128<8, UP, UP, 512>(Q0, K0, V0, O0, 4 * (qb + 1), (char*)lds); } }
            for (int rep = 0; rep < REP_DSWA; ++rep) attn_body::dswa_phase<8>((const abf*)U, (abf*)OA, LSE, vcu * 6, 6, (char*)lds);
        }
        SEAM(P + 1);
        if (IN(P + 2)) { PTRS();
            const float linit = l == 0 ? 0.2f : 0.35550906759096934f;
            const float s1 = wave_sum(lq1[l * 64 + lane] * lk1[l * 64 + lane]), s2 = wave_sum(lq2[l * 64 + lane] * lk2[l * 64 + lane]);
            const float lam = __expf(s1) - __expf(s2) + linit;
            const f32x4 sg0 = *(const f32x4*)(subln_g + l * 128 + (lane & 15) * 8), sg1 = *(const f32x4*)(subln_g + l * 128 + (lane & 15) * 8 + 4);
            for (int m = gw; m < M; m += NGW) {
                const int ha = lane >> 3;
                const float L0 = LSE[(size_t)m * 8 + ha], L1 = LSE[(size_t)M * 8 + (size_t)m * 8 + ha], L2 = LSE[(size_t)2 * M * 8 + (size_t)m * 8 + ha];
                const float Lm = fmaxf(L0, fmaxf(L1, L2)); float w0 = __builtin_amdgcn_exp2f(L0 - Lm), w1 = __builtin_amdgcn_exp2f(L1 - Lm), w2 = __builtin_amdgcn_exp2f(L2 - Lm);
                const float wi = __builtin_amdgcn_rcpf(w0 + w1 + w2); w0 *= wi; w1 *= wi; w2 *= wi;
                const v4u a0 = *(const v4u*)(OA + (size_t)m * 512 + lane * 8), a1 = *(const v4u*)(OA + (size_t)M * 512 + (size_t)m * 512 + lane * 8), a2 = *(const v4u*)(OA + (size_t)2 * M * 512 + (size_t)m * 512 + lane * 8);
                v4u* gp = (v4u*)(GATE + (size_t)m * DM + lane * 8); const v4u ga = *gp; v4u o;
#pragma unroll
                for (int j = 0; j < 4; ++j) { const float vl = (w0 * bflo(a0[j]) + w1 * bflo(a1[j]) + w2 * bflo(a2[j])) * bflo(ga[j]), vhh = (w0 * bfhi(a0[j]) + w1 * bfhi(a1[j]) + w2 * bfhi(a2[j])) * bfhi(ga[j]); o[j] = pk2(vl, vhh); }
                *gp = o;
                const v4u d0 = *(const v4u*)(OD + (size_t)m * 512 + lane * 8), d1 = *(const v4u*)(OD + (size_t)M * 512 + (size_t)m * 512 + lane * 8);
                v4u* gq = (v4u*)(GATE + (size_t)m * DM + 512 + lane * 8); const v4u gb = *gq;
                float dv[8]; float ss = 0.f;
#pragma unroll
                for (int j = 0; j < 4; ++j) { dv[2 * j] = bflo(d0[j]) - lam * bflo(d1[j]); dv[2 * j + 1] = bfhi(d0[j]) - lam * bfhi(d1[j]); ss += dv[2 * j] * dv[2 * j] + dv[2 * j + 1] * dv[2 * j + 1]; }
                ss += __shfl_xor(ss, 1); ss += __shfl_xor(ss, 2); ss += __shfl_xor(ss, 4); ss += __shfl_xor(ss, 8);
                const float rs = __builtin_amdgcn_rsqf(ss * (1.0f / 128.0f) + 1e-5f) * (1.0f - linit);
#pragma unroll
                for (int j = 0; j < 4; ++j) { const float g0 = j < 2 ? sg0[2 * j] : sg1[2 * j - 4], g1 = j < 2 ? sg0[2 * j + 1] : sg1[2 * j - 3]; o[j] = pk2(dv[2 * j] * rs * g0 * bflo(gb[j]), dv[2 * j + 1] * rs * g1 * bfhi(gb[j])); }
                *gq = o;
            }
        }
        SEAM(P + 2);
        if (IN(P + 3)) { PTRS();
            for (int rep = 0; rep < (l == 0 ? REP_G2 : 1); ++rep) { pg8::Gemm g{GATE, WOUT + (size_t)l * DM * DM, M, DM, DM}; pg8::StaticOrder S; S.init(M, DM, G, bx);
              pg8::EpiRes<l == 0> E{x, HB2, HB1, SSQB};
              pg8::gemm_phase<pg8::EpiRes<l == 0>, pg8::StaticOrder, PG8_ALIGN, PG8_SP2>((LAS unsigned char*)lds, g, S, E); }
            for (int rep = 0; rep < REP_E; ++rep) { pg8::Gemm g{PB + (size_t)l * M * PLE, WPLE + (size_t)l * PLE * DM, M, DM, PLE}; pg8::StaticOrder S; S.init(M, DM, G, bx);
              pg8::EpiE E{EB};
              pg8::gemm_phase<pg8::EpiE, pg8::StaticOrder, PG8_ALIGN, PG8_SP2>((LAS unsigned char*)lds, g, S, E); }
        }
        SEAM(P + 3);
        if (IN(P + 4)) { PTRS();
            pg8::Gemm g{HB1, WGATE + (size_t)l * DM * DM, M, DM, DM}; pg8::StaticOrder S; S.init(M, DM, G, bx);
            for (int rep = 0; rep < REP_G3D; ++rep) { pg8::EpiE E{OA}; pg8::gemm_phase<pg8::EpiE, pg8::StaticOrder, PG8_ALIGN, PG8_SP2>((LAS unsigned char*)lds, g, S, E); }
            if constexpr (l == 0) { pg8::EpiPle E{HB1, EB, HB2, SSQB, SSQA};
                pg8::gemm_phase<pg8::EpiPle, pg8::StaticOrder, PG8_ALIGN, PG8_SP2>((LAS unsigned char*)lds, g, S, E); }
            else {
                pg8::EpiPleFinal E{HB1, EB, SSQB, SSQA, (unsigned*)(ws + WS_CTL) + 8192, final_g, H};
                pg8::gemm_phase<pg8::EpiPleFinal, pg8::StaticOrder, false, PG8_SP2>((LAS unsigned char*)lds, g, S, E); }
        }
        if constexpr (l == 0) SEAM(P + 4);
    };
    layer(std::integral_constant<int, 0>{});
    layer(std::integral_constant<int, 1>{});
#undef IN
#undef SEAM
}

extern "C" void kernel_launch(void* const* d_in, const int* in_sizes, int n_in, void* d_out, int out_size, void* d_ws, size_t ws_size, hipStream_t stream) {
    static int grid = 0;
    if (grid == 0) {
        if (n_in != 14 || out_size != M * DM || ws_size < WS_END) { fprintf(stderr, "kernel_launch: unexpected shapes (n_in %d out %d ws %zu)\n", n_in, out_size, ws_size); grid = -1; return; }
        int dev = 0, cus = 0, per_cu = 0;
        hipGetDevice(&dev); hipDeviceGetAttribute(&cus, hipDeviceAttributeMultiprocessorCount, dev);
        if (hipFuncSetAttribute((const void*)hymba_fwd, hipFuncAttributeMaxDynamicSharedMemorySize, LDS_BYTES) != hipSuccess) { fprintf(stderr, "kernel_launch: hipFuncSetAttribute failed\n"); grid = -1; return; }
        if (hipOccupancyMaxActiveBlocksPerMultiprocessor(&per_cu, (const void*)hymba_fwd, NWAVES * 64, LDS_BYTES) != hipSuccess || per_cu < 1) { fprintf(stderr, "kernel_launch: occupancy query says %d\n", per_cu); per_cu = 1; }
        (void)hipGetLastError();
        grid = cus * (per_cu > 1 ? 1 : per_cu);
        fprintf(stderr, "kernel_launch: grid %d (cus %d, per_cu %d)\n", grid, cus, per_cu);
    }
    if (grid < 0) return;
    if (hipMemsetAsync((char*)d_ws + WS_CTL, 0, CTL_ZERO_BYTES, stream) != hipSuccess) { fprintf(stderr, "kernel_launch: memset failed\n"); return; }
    Args a{};
    for (int i = 0; i < 14; ++i) a.in[i] = (const float*)d_in[i];
    a.out = (float*)d_out; a.ws = (unsigned char*)d_ws;
    for (int li = 0; li < MK_N_LAUNCHES; ++li) {
        a.ph_lo = (MK_N_LAUNCHES == 1) ? 0 : li; a.ph_hi = (MK_N_LAUNCHES == 1) ? NPHASE : li + 1;
        void* kargs[] = {&a};
        const hipError_t le = hipLaunchCooperativeKernel((const void*)hymba_fwd, dim3(grid), dim3(NWAVES * 64), kargs, LDS_BYTES, stream);
        if (le != hipSuccess) { fprintf(stderr, "kernel_launch: launch %d failed: %s\n", li, hipGetErrorName(le)); break; }
    }
}
```

```cpp
#include <hip/hip_runtime.h>
#include <hip/hip_cooperative_groups.h>
#include <cstdio>
#include <cstdint>
#include <type_traits>
namespace pg8 {
#define PG8_LAS __attribute__((address_space(3)))
typedef unsigned short bf16_t;
typedef short bf16x8 __attribute__((ext_vector_type(8)));
typedef float f32x4 __attribute__((ext_vector_type(4)));
typedef unsigned u32x4 __attribute__((ext_vector_type(4)));
constexpr int BM = 256, BK = 64, HALF = 128, HTB = HALF * BK * 2  , STAGE_BYTES = 8 * HTB, NXCD = 8, WGM = 8;

__host__ __device__ __forceinline__ int lds_byte(int r, int c) { const int st = (r >> 4) * 2 + (c >> 5), rr = r & 15, cc = c & 31, ob = rr * 64 + cc * 2; return st * 1024 + (ob ^ (((ob >> 9) & 1) << 5)); }
__host__ __device__ __forceinline__ void stage_rc(int b, int& R, int& C) { const int st = b / 1024, sb = b % 1024, swz = sb ^ (((sb >> 9) & 1) << 5); R = (st >> 1) * 16 + swz / 64; C = (st & 1) * 32 + (swz % 64) / 2; }
__host__ __device__ __forceinline__ int perm32(int rho) { const int n = rho >> 4, i = rho & 15; return 8 * (i >> 2) + 4 * n + (i & 3); }

struct Unit { int pm, pn; };
struct Gemm { const bf16_t* A; const bf16_t* Bt; int M, N, K; };

struct StaticOrder {
    int nM, nN, nwg, G, c;
    __host__ __device__ void init(int M, int N, int G_, int c_) { nM = M / BM; nN = N / BM; nwg = nM * nN; G = G_; c = c_; }
    __host__ __device__ bool next(int i, Unit& u) const {
        const long L = (long)i * G + c; if (L >= nwg) return false;
        int wgid = (int)L; { const int q = nwg / NXCD, r = nwg % NXCD, xcd = wgid % NXCD, off = wgid / NXCD; wgid = (xcd < r ? xcd * (q + 1) : r * (q + 1) + (xcd - r) * q) + off; }
        const int nig = WGM * nN, gid = wgid / nig, fm = gid * WGM, gsz = (nM - fm) < WGM ? (nM - fm) : WGM;
        u.pm = fm + ((wgid % nig) % gsz); u.pn = (wgid % nig) / gsz; return true;
    }
    __device__ __forceinline__ void a_ready(const Unit&) const {}
    __device__ __forceinline__ void done(const Unit&) const {}
};

__device__ __forceinline__ unsigned cvt_pk_bf16(float lo, float hi) { unsigned r; asm volatile("v_cvt_pk_bf16_f32 %0, %1, %2" : "=v"(r) : "v"(lo), "v"(hi)); return r; }
typedef float f32x2 __attribute__((ext_vector_type(2)));
__device__ __forceinline__ f32x2 gelu_pk(f32x2 v) {
    const f32x2 av = __builtin_elementwise_abs(v), d = av * 0.2316418882f + 1.0f;
    f32x2 t; t.x = __builtin_amdgcn_rcpf(d.x); t.y = __builtin_amdgcn_rcpf(d.y);
    f32x2 q = t * 0.5307027145f + (-0.7265760135f); q = q * t + 0.7107068705f; q = q * t + (-0.142248368f); q = q * t + 0.127414796f; q = q * t;
    const f32x2 s = (v * v) * (-0.72134752044f);
    f32x2 e; e.x = __builtin_amdgcn_exp2f(s.x); e.y = __builtin_amdgcn_exp2f(s.y);
    const f32x2 m = v * (q * e), r = v - m;
    f32x2 o; o.x = v.x < 0.f ? m.x : r.x; o.y = v.y < 0.f ? m.y : r.y; return o;
}

template <int ACT  > struct EpiBf16 {
    static constexpr bool PERM = true, AFTER_DRAIN = false; static_assert(ACT == 0 || ACT == 1, "EpiBf16: ACT is 0 (none) or 1 (gelu_pk)");
    bf16_t* O; int ldc; const float* bias; int split_cols; size_t split_stride; float scale0;
    __device__ __forceinline__ void operator()(const f32x4 (&acc)[2][2][4][2], const Unit& u, int wr, int wc, int fr, int fq) const {
        const int row0 = u.pm * BM + wr * 64 + fr; int colt = u.pn * BM; bf16_t* base = O;
        float sc = 1.f; if (split_cols) { const int t = colt / split_cols; base += (size_t)t * split_stride; colt -= t * split_cols; if (t == 0) sc = scale0; }
        const int col0 = colt + wc * 32 + 8 * fq, bcol0 = u.pn * BM + wc * 32 + 8 * fq;
        f32x4 bv[2][2];
#pragma unroll
        for (int bj = 0; bj < 2; ++bj)
#pragma unroll
            for (int n = 0; n < 2; ++n) bv[bj][n] = bias ? *(const f32x4*)(bias + bcol0 + bj * HALF + 4 * n) : (f32x4){0.f, 0.f, 0.f, 0.f};
#pragma unroll
        for (int ai = 0; ai < 2; ++ai)
#pragma unroll
            for (int m = 0; m < 4; ++m) { bf16_t* rowp = base + (size_t)(row0 + ai * HALF + m * 16) * ldc + col0;
#pragma unroll
                for (int bj = 0; bj < 2; ++bj) { f32x4 v0 = acc[ai][bj][m][0] + bv[bj][0], v1 = acc[ai][bj][m][1] + bv[bj][1];
                    if (ACT == 1) { f32x2 a = gelu_pk((f32x2){v0[0], v0[1]}), b = gelu_pk((f32x2){v0[2], v0[3]}), c = gelu_pk((f32x2){v1[0], v1[1]}), d = gelu_pk((f32x2){v1[2], v1[3]});
                        v0 = (f32x4){a.x, a.y, b.x, b.y}; v1 = (f32x4){c.x, c.y, d.x, d.y}; }
                    v0 = v0 * sc; v1 = v1 * sc; u32x4 w; w.x = cvt_pk_bf16(v0[0], v0[1]); w.y = cvt_pk_bf16(v0[2], v0[3]); w.z = cvt_pk_bf16(v1[0], v1[1]); w.w = cvt_pk_bf16(v1[2], v1[3]);
                    *(u32x4*)(rowp + bj * HALF) = w; } }
    }
};

__device__ __forceinline__ float ssq16(const float* p) { const f32x4 a = ((const f32x4*)p)[0], b = ((const f32x4*)p)[1], c = ((const f32x4*)p)[2], d = ((const f32x4*)p)[3];
    return (((a[0] + a[1]) + (a[2] + a[3])) + ((b[0] + b[1]) + (b[2] + b[3]))) + (((c[0] + c[1]) + (c[2] + c[3])) + ((d[0] + d[1]) + (d[2] + d[3]))); }
__device__ __forceinline__ float rstd_of(const float* p) { return __builtin_amdgcn_rsqf(ssq16(p) * (1.0f / 1024.0f) + 1e-6f); }
__device__ __forceinline__ float sigm(float x) { return __builtin_amdgcn_rcpf(1.0f + __builtin_amdgcn_exp2f(-1.4426950408889634f * x)); }
constexpr float QSCALE = 0.125f * 1.4426950408889634f;
struct EpiQKVG {
    static constexpr bool PERM = true, AFTER_DRAIN = false;
    bf16_t* U; bf16_t* GATE; const PG8_LAS float* rsl; const PG8_LAS float* rope;
    __device__ __forceinline__ void operator()(const f32x4 (&acc)[2][2][4][2], const Unit& u, int wr, int wc, int fr, int fq) const {
        const int type = u.pn >> 1, t3 = type & 3;
        const bool isg = t3 == 3, isq = t3 == 0;
        bf16_t* base; int ld, colt;
        if (isg) { base = GATE; ld = 1024; colt = (type >> 2) * 512 + (u.pn & 1) * 256; }
        else { base = U; ld = 3072; colt = ((type >> 2) * 3 + t3) * 512 + (u.pn & 1) * 256; }
        const int col0 = colt + wc * 32 + 8 * fq;
        const bool ropew = (t3 <= 1) && ((wc & 1) == 0);
#pragma unroll
        for (int ai = 0; ai < 2; ++ai)
#pragma unroll
            for (int m = 0; m < 4; ++m) {
                if ((m & 1) == 0) asm volatile("" ::: "memory");
                const int row = u.pm * BM + wr * 64 + ai * HALF + m * 16 + fr;
                const float rs = rsl[wr * 64 + ai * HALF + m * 16 + fr];
                const float sc = isq ? rs * QSCALE : rs;
                f32x4 cc = {1.f, 1.f, 1.f, 1.f}, ss = {0.f, 0.f, 0.f, 0.f};
                if (ropew && fq < 2) { const PG8_LAS f32x4* rp = (const PG8_LAS f32x4*)(rope + (wr * 64 + ai * HALF + m * 16 + fr) * 16); cc = rp[fq]; ss = rp[2 + fq]; }
                bf16_t* rowp = base + (size_t)row * ld + col0;
#pragma unroll
                for (int bj = 0; bj < 2; ++bj) {
                    f32x4 v0 = acc[ai][bj][m][0] * sc, v1 = acc[ai][bj][m][1] * sc;
                    if (ropew) {
                        const f32x4 a0 = v0, a1 = v1;
                        v0[0] = a0[0] * cc[0] - a0[1] * ss[0]; v0[1] = a0[1] * cc[0] + a0[0] * ss[0]; v0[2] = a0[2] * cc[1] - a0[3] * ss[1]; v0[3] = a0[3] * cc[1] + a0[2] * ss[1];
                        v1[0] = a1[0] * cc[2] - a1[1] * ss[2]; v1[1] = a1[1] * cc[2] + a1[0] * ss[2]; v1[2] = a1[2] * cc[3] - a1[3] * ss[3]; v1[3] = a1[3] * cc[3] + a1[2] * ss[3];
                    }
                    if (isg) {
#pragma unroll
                        for (int i = 0; i < 4; ++i) { v0[i] = v0[i] * sigm(v0[i]); v1[i] = v1[i] * sigm(v1[i]); }
                    }
                    u32x4 w; w.x = cvt_pk_bf16(v0[0], v0[1]); w.y = cvt_pk_bf16(v0[2], v0[3]); w.z = cvt_pk_bf16(v1[0], v1[1]); w.w = cvt_pk_bf16(v1[2], v1[3]);
                    *(u32x4*)(rowp + bj * HALF) = w;
                }
            }
    }
};
typedef unsigned u32x2 __attribute__((ext_vector_type(2)));
__device__ __forceinline__ f32x4 bf4(u32x2 e) { f32x4 r; r[0] = __uint_as_float(e.x << 16); r[1] = __uint_as_float(e.x & 0xffff0000u); r[2] = __uint_as_float(e.y << 16); r[3] = __uint_as_float(e.y & 0xffff0000u); return r; }
template <bool HIN_F32> struct EpiRes {
    static constexpr bool PERM = false, AFTER_DRAIN = false;
    const float* hin32; const bf16_t* hin16; bf16_t* hb; float* ssq;
    __device__ __forceinline__ void operator()(const f32x4 (&acc)[2][2][4][2], const Unit& u, int wr, int wc, int fr, int fq) const {
        const int col0 = u.pn * BM + wc * 32 + 4 * fq;
#pragma unroll
        for (int ai = 0; ai < 2; ++ai) {
            asm volatile("" ::: "memory");
            f32x4 hv[4][2][2];
#pragma unroll
            for (int m = 0; m < 4; ++m) { const size_t off = (size_t)(u.pm * BM + wr * 64 + ai * HALF + m * 16 + fr) * 1024 + col0;
#pragma unroll
                for (int bj = 0; bj < 2; ++bj)
#pragma unroll
                    for (int n = 0; n < 2; ++n) { if (HIN_F32) hv[m][bj][n] = *(const f32x4*)(hin32 + off + bj * HALF + 16 * n); else hv[m][bj][n] = bf4(*(const u32x2*)(hin16 + off + bj * HALF + 16 * n)); } }
#pragma unroll
            for (int m = 0; m < 4; ++m) {
                const int row = u.pm * BM + wr * 64 + ai * HALF + m * 16 + fr;
                const size_t off = (size_t)row * 1024 + col0; float part = 0.f;
#pragma unroll
                for (int bj = 0; bj < 2; ++bj)
#pragma unroll
                    for (int n = 0; n < 2; ++n) {
                        const f32x4 v = hv[m][bj][n] + acc[ai][bj][m][n];
                        part += (v[0] * v[0] + v[1] * v[1]) + (v[2] * v[2] + v[3] * v[3]);
                        u32x2 w; w.x = cvt_pk_bf16(v[0], v[1]); w.y = cvt_pk_bf16(v[2], v[3]);
                        *(u32x2*)(hb + off + bj * HALF + 16 * n) = w;
                    }
                part += __shfl_xor(part, 16); part += __shfl_xor(part, 32);
                if (fq == 0) ssq[(size_t)row * 16 + u.pn * 4 + wc] = part;
            }
        }
    }
};
struct EpiE {
    static constexpr bool PERM = true, AFTER_DRAIN = false;
    bf16_t* E;
    __device__ __forceinline__ void operator()(const f32x4 (&acc)[2][2][4][2], const Unit& u, int wr, int wc, int fr, int fq) const {
        const int col0 = u.pn * BM + wc * 32 + 8 * fq;
#pragma unroll
        for (int ai = 0; ai < 2; ++ai)
#pragma unroll
            for (int m = 0; m < 4; ++m) {
                const int row = u.pm * BM + wr * 64 + ai * HALF + m * 16 + fr;
#pragma unroll
                for (int bj = 0; bj < 2; ++bj) { const f32x4 v0 = acc[ai][bj][m][0], v1 = acc[ai][bj][m][1];
                    u32x4 w; w.x = cvt_pk_bf16(v0[0], v0[1]); w.y = cvt_pk_bf16(v0[2], v0[3]); w.z = cvt_pk_bf16(v1[0], v1[1]); w.w = cvt_pk_bf16(v1[2], v1[3]);
                    *(u32x4*)(E + (size_t)row * 1024 + col0 + bj * HALF) = w; }
            }
    }
};
__device__ __forceinline__ float rstd_q(const float* p, int fq) {
    const f32x4 a = ((const f32x4*)p)[fq]; float s = (a[0] + a[1]) + (a[2] + a[3]); s += __shfl_xor(s, 16); s += __shfl_xor(s, 32);
    return __builtin_amdgcn_rsqf(s * (1.0f / 1024.0f) + 1e-6f); }
struct EpiPle {
    static constexpr bool PERM = false, AFTER_DRAIN = false;
    const bf16_t* H; const bf16_t* E; bf16_t* hb; const float* ssq_in; float* ssq_out;
    __device__ __forceinline__ void operator()(const f32x4 (&acc)[2][2][4][2], const Unit& u, int wr, int wc, int fr, int fq) const {
        const int col0 = u.pn * BM + wc * 32 + 4 * fq;
#pragma unroll
        for (int ai = 0; ai < 2; ++ai) {
            asm volatile("" ::: "memory");
            u32x2 hv[4][2][2], ev[4][2][2]; float rs[4];
#pragma unroll
            for (int m = 0; m < 4; ++m) { const int row = u.pm * BM + wr * 64 + ai * HALF + m * 16 + fr; const size_t off = (size_t)row * 1024 + col0;
                rs[m] = rstd_q(ssq_in + (size_t)row * 16, fq);
#pragma unroll
                for (int bj = 0; bj < 2; ++bj)
#pragma unroll
                    for (int n = 0; n < 2; ++n) { hv[m][bj][n] = *(const u32x2*)(H + off + bj * HALF + 16 * n); ev[m][bj][n] = *(const u32x2*)(E + off + bj * HALF + 16 * n); } }
#pragma unroll
            for (int m = 0; m < 4; ++m) {
                const int row = u.pm * BM + wr * 64 + ai * HALF + m * 16 + fr;
                const size_t off = (size_t)row * 1024 + col0; float part = 0.f;
#pragma unroll
                for (int bj = 0; bj < 2; ++bj)
#pragma unroll
                    for (int n = 0; n < 2; ++n) {
                        const f32x4 a = bf4(hv[m][bj][n]), ef = bf4(ev[m][bj][n]);
                        f32x4 v;
#pragma unroll
                        for (int i = 0; i < 4; ++i) v[i] = a[i] + ef[i] * sigm(acc[ai][bj][m][n][i] * rs[m]);
                        part += (v[0] * v[0] + v[1] * v[1]) + (v[2] * v[2] + v[3] * v[3]);
                        u32x2 w; w.x = cvt_pk_bf16(v[0], v[1]); w.y = cvt_pk_bf16(v[2], v[3]);
                        *(u32x2*)(hb + off + bj * HALF + 16 * n) = w;
                    }
                part += __shfl_xor(part, 16); part += __shfl_xor(part, 32);
                if (fq == 0) ssq_out[(size_t)row * 16 + u.pn * 4 + wc] = part;
            }
        }
    }
};

struct EpiPleFinal {
    static constexpr bool PERM = false, AFTER_DRAIN = true;
    const bf16_t* H; const bf16_t* E; const float* ssq_in; float* ssq_out; unsigned* cnt; const float* gfin; float* out;
    __device__ __forceinline__ void fused(f32x4 (&acc)[2][2][4][2], const Unit& u, int wr, int wc, int fr, int fq, PG8_LAS unsigned char*, int, int lane) const {
        const int col0 = u.pn * BM + wc * 32 + 4 * fq;
#pragma unroll
        for (int ai = 0; ai < 2; ++ai)
#pragma unroll
            for (int m = 0; m < 4; ++m) {
                if ((m & 1) == 0) asm volatile("" ::: "memory");
                const int row = u.pm * BM + wr * 64 + ai * HALF + m * 16 + fr;
                const float rs = rstd_q(ssq_in + (size_t)row * 16, fq);
                const size_t off = (size_t)row * 1024 + col0; float part = 0.f;
#pragma unroll
                for (int bj = 0; bj < 2; ++bj)
#pragma unroll
                    for (int n = 0; n < 2; ++n) {
                        const f32x4 a = bf4(*(const u32x2*)(H + off + bj * HALF + 16 * n)), ef = bf4(*(const u32x2*)(E + off + bj * HALF + 16 * n));
                        f32x4 v;
#pragma unroll
                        for (int i = 0; i < 4; ++i) v[i] = a[i] + ef[i] * sigm(acc[ai][bj][m][n][i] * rs);
                        acc[ai][bj][m][n] = v;
                        part += (v[0] * v[0] + v[1] * v[1]) + (v[2] * v[2] + v[3] * v[3]);
                    }
                part += __shfl_xor(part, 16); part += __shfl_xor(part, 32);
                if (fq == 0) __hip_atomic_store(ssq_out + (size_t)row * 16 + u.pn * 4 + wc, part, __ATOMIC_RELAXED, __HIP_MEMORY_SCOPE_AGENT);
                asm volatile("" : "+v"(acc[ai][0][m][0]), "+v"(acc[ai][0][m][1]), "+v"(acc[ai][1][m][0]), "+v"(acc[ai][1][m][1]));
            }
        asm volatile("s_waitcnt vmcnt(0)" ::: "memory");
        unsigned* c = cnt + 64 * u.pm;
        if (lane == 0) __hip_atomic_fetch_add(c, 1u, __ATOMIC_RELAXED, __HIP_MEMORY_SCOPE_AGENT);
        { unsigned sp = 0;
          while ((unsigned)__builtin_amdgcn_readfirstlane(__hip_atomic_load(c, __ATOMIC_RELAXED, __HIP_MEMORY_SCOPE_AGENT)) < 32u) { __builtin_amdgcn_s_sleep(2); if (++sp > (1u << 22)) break; } }
        __builtin_amdgcn_fence(__ATOMIC_ACQUIRE, "agent");
        f32x4 g[2][2];
#pragma unroll
        for (int bj = 0; bj < 2; ++bj) { g[bj][0] = *(const f32x4*)(gfin + col0 + bj * HALF); g[bj][1] = *(const f32x4*)(gfin + col0 + bj * HALF + 16); }
#pragma unroll
        for (int ai = 0; ai < 2; ++ai)
#pragma unroll
            for (int m = 0; m < 4; ++m) {
                if (m == 0) asm volatile("" ::: "memory");
                const int row = u.pm * BM + wr * 64 + ai * HALF + m * 16 + fr;
                const float rs = rstd_q(ssq_out + (size_t)row * 16, fq);
                const size_t off = (size_t)row * 1024 + col0;
#pragma unroll
                for (int bj = 0; bj < 2; ++bj) { *(f32x4*)(out + off + bj * HALF) = acc[ai][bj][m][0] * rs * g[bj][0]; *(f32x4*)(out + off + bj * HALF + 16) = acc[ai][bj][m][1] * rs * g[bj][1]; }
            }
    }
};


template <class Epi, class Sched, bool ALIGN_EPI = false, bool SP2 = false>
__device__ __forceinline__ void gemm_phase(PG8_LAS unsigned char* lds, const Gemm g, const Sched& S, const Epi& E) {
    int tid = threadIdx.x; asm volatile("" : "+v"(tid)); const int wid = __builtin_amdgcn_readfirstlane(tid >> 6), lane = tid & 63, wr = wid >> 2, wc = wid & 3, fr = lane & 15, fq = lane >> 4;
    const int K = g.K, nt = K / BK;
    unsigned voffA[2], voffB[2];
#pragma unroll
    for (int i = 0; i < 2; ++i) { int R, C; stage_rc(tid * 16 + i * 8192, R, C); const int Rb = Epi::PERM ? ((R & ~31) + perm32(R & 31)) : R;
        voffA[i] = (unsigned)(R * K + C) * 2u; voffB[i] = (unsigned)(Rb * K + C) * 2u; }
    const size_t kstep = (size_t)(BK * 2);
    const size_t hstep = (size_t)HALF * K * 2;
    const size_t tstep = 2 * hstep;
    const unsigned ldsw = (unsigned)wid * 1024u;
    const int aoff = lds_byte(wr * 64 + fr, fq * 8), boff = lds_byte(wc * 32 + fr, fq * 8);
#define PG8_SA(b, h) (((b) * 2 + (h)) * HTB)
#define PG8_SB(b, h) ((4 + (b) * 2 + (h)) * HTB)
#define PG8_STAGE(bufoff, gbase, voff) do { _Pragma("unroll") for (int _i = 0; _i < 2; ++_i) \
        __builtin_amdgcn_global_load_lds((const unsigned*)((const char*)(gbase) + (voff)[_i]), (PG8_LAS unsigned*)(lds + (bufoff) + ldsw + _i * 8192), 16, 0, 0); } while (0)
#define PG8_LDA(dst, b, h) do { _Pragma("unroll") for (int m = 0; m < 4; ++m) _Pragma("unroll") for (int k = 0; k < 2; ++k) dst[m][k] = *(const PG8_LAS bf16x8*)(lds + PG8_SA(b, h) + aoff + m * 2048 + k * 1024); } while (0)
#define PG8_LDB(dst, b, h) do { _Pragma("unroll") for (int n = 0; n < 2; ++n) _Pragma("unroll") for (int k = 0; k < 2; ++k) dst[n][k] = *(const PG8_LAS bf16x8*)(lds + PG8_SB(b, h) + boff + n * 2048 + k * 1024); } while (0)
#define PG8_MMA(ai, bj, At, Bt) do { __builtin_amdgcn_s_setprio(1); _Pragma("unroll") for (int m = 0; m < 4; ++m) _Pragma("unroll") for (int n = 0; n < 2; ++n) _Pragma("unroll") for (int k = 0; k < 2; ++k) \
        acc[ai][bj][m][n] = __builtin_amdgcn_mfma_f32_16x16x32_bf16(Bt[n][k], At[m][k], acc[ai][bj][m][n], 0, 0, 0); __builtin_amdgcn_s_setprio(0); } while (0)
#define PG8_WAIT_V(n) asm volatile("s_waitcnt vmcnt(" #n ")" ::: "memory")
#define PG8_WAIT_L(n) asm volatile("s_waitcnt lgkmcnt(" #n ")" ::: "memory")
#define PG8_BAR __builtin_amdgcn_s_barrier()
#define PG8_SCHED __builtin_amdgcn_sched_barrier(0)
    Unit cur, nxt; int ui = 0;
    if (!S.next(0, cur)) return;
    f32x4 acc[2][2][4][2];
#pragma unroll
    for (int a = 0; a < 2; ++a)
#pragma unroll
        for (int b = 0; b < 2; ++b)
#pragma unroll
            for (int m = 0; m < 4; ++m)
#pragma unroll
                for (int n = 0; n < 2; ++n) acc[a][b][m][n] = (f32x4){0.f, 0.f, 0.f, 0.f};
    bf16x8 At[4][2], B0[2][2], B1[2][2];
    const char* cA = (const char*)g.A + (size_t)cur.pm * tstep; const char* cB = (const char*)g.Bt + (size_t)cur.pn * tstep;
    S.a_ready(cur);
    if constexpr (SP2) {
        PG8_STAGE(PG8_SB(0, 0), cB, voffB); PG8_STAGE(PG8_SB(0, 1), cB + hstep, voffB); PG8_STAGE(PG8_SA(0, 0), cA, voffA); PG8_STAGE(PG8_SA(0, 1), cA + hstep, voffA);
        if (wr == 1) PG8_BAR;
        PG8_WAIT_V(2); PG8_BAR;
        PG8_STAGE(PG8_SB(1, 0), cB + kstep, voffB); PG8_STAGE(PG8_SA(1, 0), cA + kstep, voffA); PG8_STAGE(PG8_SB(1, 1), cB + hstep + kstep, voffB);
        PG8_WAIT_V(6); PG8_BAR;
    } else {
        PG8_STAGE(PG8_SB(0, 0), cB, voffB); PG8_STAGE(PG8_SA(0, 0), cA, voffA); PG8_STAGE(PG8_SB(0, 1), cB + hstep, voffB); PG8_STAGE(PG8_SA(0, 1), cA + hstep, voffA);
        if (wr == 1) PG8_BAR;
        PG8_WAIT_V(4); PG8_BAR;
        PG8_STAGE(PG8_SB(1, 0), cB + kstep, voffB); PG8_STAGE(PG8_SA(1, 0), cA + kstep, voffA); PG8_STAGE(PG8_SB(1, 1), cB + hstep + kstep, voffB);
        PG8_WAIT_V(6); PG8_BAR;
    }
    for (;;) {
        const bool has_next = S.next(ui + 1, nxt);
        const char* nA = has_next ? (const char*)g.A + (size_t)nxt.pm * tstep : cA; const char* nB = has_next ? (const char*)g.Bt + (size_t)nxt.pn * tstep : cB;
        for (int t = 0; t < nt; t += 2) {
            const bool last = (t == nt - 2);
            const char* a1 = cA + (size_t)(t + 1) * kstep;
            const char* a2 = last ? nA : cA + (size_t)(t + 2) * kstep; const char* b2 = last ? nB : cB + (size_t)(t + 2) * kstep;
            const char* a3 = a2 + kstep; const char* b3 = b2 + kstep;
            if (last && has_next) S.a_ready(nxt);
            if constexpr (SP2) {
            PG8_LDB(B0, 0, 0); PG8_LDB(B1, 0, 1); PG8_SCHED; PG8_LDA(At, 0, 0); PG8_STAGE(PG8_SA(1, 1), a1 + hstep, voffA);
            PG8_WAIT_V(8); PG8_WAIT_L(0); PG8_BAR; PG8_MMA(0, 0, At, B0); PG8_MMA(0, 1, At, B1); PG8_BAR; PG8_SCHED;
            PG8_LDA(At, 0, 1); PG8_STAGE(PG8_SB(0, 0), b2, voffB); PG8_STAGE(PG8_SB(0, 1), b2 + hstep, voffB); PG8_STAGE(PG8_SA(0, 0), a2, voffA);
            PG8_WAIT_V(8); PG8_WAIT_L(0); PG8_BAR; PG8_MMA(1, 0, At, B0); PG8_MMA(1, 1, At, B1); PG8_BAR; PG8_SCHED;
            PG8_LDB(B0, 1, 0); PG8_LDB(B1, 1, 1); PG8_SCHED; PG8_LDA(At, 1, 0); PG8_STAGE(PG8_SA(0, 1), a2 + hstep, voffA);
            PG8_WAIT_V(8); PG8_WAIT_L(0); PG8_BAR; PG8_MMA(0, 0, At, B0); PG8_MMA(0, 1, At, B1); PG8_BAR; PG8_SCHED;
            PG8_LDA(At, 1, 1); PG8_STAGE(PG8_SB(1, 0), b3, voffB); PG8_STAGE(PG8_SB(1, 1), b3 + hstep, voffB); PG8_STAGE(PG8_SA(1, 0), a3, voffA);
            PG8_WAIT_V(8); PG8_WAIT_L(0); PG8_BAR; PG8_MMA(1, 0, At, B0); PG8_MMA(1, 1, At, B1); PG8_BAR; PG8_SCHED;
            } else {
            PG8_LDB(B0, 0, 0); PG8_SCHED; PG8_LDA(At, 0, 0); PG8_STAGE(PG8_SA(1, 1), a1 + hstep, voffA);
            PG8_WAIT_L(8); PG8_BAR; PG8_WAIT_L(0); PG8_MMA(0, 0, At, B0); PG8_BAR; PG8_SCHED;
            PG8_LDB(B1, 0, 1); PG8_STAGE(PG8_SB(0, 0), b2, voffB);
            PG8_BAR; PG8_WAIT_L(0); PG8_MMA(0, 1, At, B1); PG8_BAR;
            PG8_LDA(At, 0, 1); PG8_STAGE(PG8_SA(0, 0), a2, voffA);
            PG8_BAR; PG8_WAIT_L(0); PG8_MMA(1, 0, At, B0); PG8_BAR; PG8_SCHED;
            PG8_STAGE(PG8_SB(0, 1), b2 + hstep, voffB);
            PG8_WAIT_V(6); PG8_BAR; PG8_MMA(1, 1, At, B1); PG8_BAR;
            PG8_LDB(B0, 1, 0); PG8_SCHED; PG8_LDA(At, 1, 0); PG8_STAGE(PG8_SA(0, 1), a2 + hstep, voffA);
            PG8_WAIT_L(8); PG8_BAR; PG8_WAIT_L(0); PG8_MMA(0, 0, At, B0); PG8_BAR; PG8_SCHED;
            PG8_LDB(B1, 1, 1); PG8_STAGE(PG8_SB(1, 0), b3, voffB);
            PG8_BAR; PG8_WAIT_L(0); PG8_MMA(0, 1, At, B1); PG8_BAR;
            PG8_LDA(At, 1, 1); PG8_STAGE(PG8_SA(1, 0), a3, voffA);
            PG8_BAR; PG8_WAIT_L(0); PG8_MMA(1, 0, At, B0); PG8_BAR; PG8_SCHED;
            PG8_STAGE(PG8_SB(1, 1), b3 + hstep, voffB);
            PG8_WAIT_V(6); PG8_BAR; PG8_MMA(1, 1, At, B1); PG8_BAR;
            }
        }
        if constexpr (ALIGN_EPI) { if (wr == 0) PG8_BAR; }
        if constexpr (!Epi::AFTER_DRAIN) { E(acc, cur, wr, wc, fr, fq); S.done(cur); }
        if (!has_next) break;
#pragma unroll
        for (int a = 0; a < 2; ++a)
#pragma unroll
            for (int b = 0; b < 2; ++b)
#pragma unroll
                for (int m = 0; m < 4; ++m)
#pragma unroll
                    for (int n = 0; n < 2; ++n) acc[a][b][m][n] = (f32x4){0.f, 0.f, 0.f, 0.f};
        cur = nxt; cA = nA; cB = nB; ++ui;
        if constexpr (ALIGN_EPI) { if (wr == 1) PG8_BAR; }
    }
    PG8_WAIT_V(0);
    if constexpr (!ALIGN_EPI) { if (wr == 0) PG8_BAR; }
    PG8_BAR;
    if constexpr (Epi::AFTER_DRAIN) { E.fused(acc, cur, wr, wc, fr, fq, lds, wid, lane); S.done(cur); }
#undef PG8_SA
#undef PG8_SB
#undef PG8_STAGE
#undef PG8_LDA
#undef PG8_LDB
#undef PG8_MMA
#undef PG8_WAIT_V
#undef PG8_WAIT_L
#undef PG8_BAR
#undef PG8_SCHED
}
}

#ifndef PG8_SP2
#define PG8_SP2 true
#endif
#ifndef PG8_ALIGN
#define PG8_ALIGN true
#endif
#include <hip/hip_bf16.h>
#include <cmath>
namespace attn_body {
using bf16=__hip_bfloat16;
using bf16x8=__attribute__((ext_vector_type(8)))short;
using s16x4=__attribute__((ext_vector_type(4)))short;
using f32x16=__attribute__((ext_vector_type(16)))float;
using u32x4=__attribute__((ext_vector_type(4)))unsigned;
constexpr int BATCH=2,SEQ=8192,D=64;
constexpr int NW=8,QBLK=32,QB=QBLK*NW,KVBLK=64;
__device__ __forceinline__ int crow(int r,int hi){return (r&3)+8*(r>>2)+4*hi;}
#define SBAR() __builtin_amdgcn_sched_barrier(0)
template<int MODE> __device__ __forceinline__ void amask(f32x16&p0,f32x16&p1,int t,int NT,int joff,int qrel,int hi){
  const float NEG=-INFINITY;
  if(MODE==0){ const int jb=t-(NT-4); if(jb<0)return; const int kb=64*jb+4*hi;
    #pragma unroll
    for(int r=0;r<16;++r){int kv=kb+(r&3)+8*(r>>2); if(kv>qrel)p0[r]=NEG; if(kv+32>qrel)p1[r]=NEG;}
  } else { const int kb=64*(t+joff)+4*hi-qrel;
    #pragma unroll
    for(int r=0;r<16;++r){int dv=kb+(r&3)+8*(r>>2); if((unsigned)dv>128u)p0[r]=NEG; if((unsigned)(dv+32)>128u)p1[r]=NEG;}
  }
}

constexpr int NSLOT=3, SLOTB=8192;
constexpr int LDS_K=0, LDS_V=NSLOT*SLOTB, LDS_WS=2*NSLOT*SLOTB, LDS_OST=LDS_WS+NW*64*4, LDS_BYTES=LDS_OST+NW*4096;
constexpr float C2=0.125f*1.4426950408889634f;
__device__ __forceinline__ void glds16(const void*sbase,unsigned voff,unsigned lds_dst){unsigned keep;
  asm volatile("s_mov_b32 %0, m0\n\ts_mov_b32 m0, %3\n\ts_nop 0\n\tglobal_load_lds_dwordx4 %1, %2\n\ts_mov_b32 m0, %0":"=&s"(keep):"v"(voff),"s"(sbase),"s"(lds_dst):"memory");}
__device__ __forceinline__ float max3f(float a,float b,float c){float r;asm("v_max3_f32 %0, %1, %2, %3":"=v"(r):"v"(a),"v"(b),"v"(c));return r;}
__device__ __forceinline__ float max2f(float a,float b){float r;asm("v_max_f32_e32 %0, %1, %2":"=v"(r):"v"(a),"v"(b));return r;}
__device__ __forceinline__ float fadd_s(float a,float b){float r;asm("v_add_f32_e32 %0, %1, %2":"=v"(r):"v"(a),"v"(b));return r;}
__device__ __forceinline__ float fsub_s(float a,float b){float r;asm("v_sub_f32_e32 %0, %1, %2":"=v"(r):"v"(a),"v"(b));return r;}
typedef float f32x2_t __attribute__((ext_vector_type(2))); typedef __bf16 bf16x2_t __attribute__((ext_vector_type(2)));
__device__ __forceinline__ unsigned cvtpk_s(float lo,float hi){f32x2_t v={lo,hi};bf16x2_t b=__builtin_convertvector(v,bf16x2_t);return __builtin_bit_cast(unsigned,b);}
#define WAIT_BAR(N) asm volatile("s_waitcnt vmcnt(" #N ") lgkmcnt(0)\n\ts_barrier":::"memory")

__device__ __forceinline__ void qkt(f32x16&p0,f32x16&p1,const char*Kslot,const bf16x8*qr,const f32x16&negm,int r32,int hi){
  const char*kb=Kslot+hi*1024+r32*16;
  #pragma unroll
  for(int d0=0;d0<4;++d0){
    const bf16x8 b0=*reinterpret_cast<const bf16x8*>(kb+d0*2048);
    const bf16x8 b1=*reinterpret_cast<const bf16x8*>(kb+d0*2048+512);
    if(d0==0){p0=__builtin_amdgcn_mfma_f32_32x32x16_bf16(b0,qr[0],negm,0,0,0);p1=__builtin_amdgcn_mfma_f32_32x32x16_bf16(b1,qr[0],negm,0,0,0);}
    else{p0=__builtin_amdgcn_mfma_f32_32x32x16_bf16(b0,qr[d0],p0,0,0,0);p1=__builtin_amdgcn_mfma_f32_32x32x16_bf16(b1,qr[d0],p1,0,0,0);}}
}
typedef __attribute__((address_space(3))) const char* lds_cptr;
typedef short v4i16_t __attribute__((ext_vector_type(4)));
__device__ __forceinline__ void kload8(bf16x8*kf,lds_cptr kp){
  kf[0]=*(const __attribute__((address_space(3))) bf16x8*)(kp);      kf[1]=*(const __attribute__((address_space(3))) bf16x8*)(kp+512);
  kf[2]=*(const __attribute__((address_space(3))) bf16x8*)(kp+2048); kf[3]=*(const __attribute__((address_space(3))) bf16x8*)(kp+2560);
  kf[4]=*(const __attribute__((address_space(3))) bf16x8*)(kp+4096); kf[5]=*(const __attribute__((address_space(3))) bf16x8*)(kp+4608);
  kf[6]=*(const __attribute__((address_space(3))) bf16x8*)(kp+6144); kf[7]=*(const __attribute__((address_space(3))) bf16x8*)(kp+6656);
}
__device__ __forceinline__ void kload2(bf16x8*kf,lds_cptr kp,int j){ kf[2*j]=*(const __attribute__((address_space(3))) bf16x8*)(kp+j*2048); kf[2*j+1]=*(const __attribute__((address_space(3))) bf16x8*)(kp+j*2048+512); }
__device__ __forceinline__ s16x4 vtr(lds_cptr p){ return __builtin_bit_cast(s16x4,__builtin_amdgcn_ds_read_tr16_b64_v4i16((__attribute__((address_space(3))) v4i16_t*)p)); }
__device__ __forceinline__ float rowmax(const f32x16&p0,const f32x16&p1){
  float a=max3f(p0[0],p0[1],p1[0]),b=max3f(p0[2],p0[3],p1[1]);a=max3f(a,p1[2],p1[3]);
  #pragma unroll
  for(int r=4;r<16;r+=4){a=max3f(a,p0[r],p0[r+1]);b=max3f(b,p0[r+2],p0[r+3]);a=max3f(a,p1[r],p1[r+1]);b=max3f(b,p1[r+2],p1[r+3]);}
  const float m=max2f(a,b);
  auto rr=__builtin_amdgcn_permlane32_swap(__float_as_uint(m),__float_as_uint(m),false,false);
  return max2f(__uint_as_float(rr[0]),__uint_as_float(rr[1]));
}
__device__ __forceinline__ void pv(f32x16*o,int vb,bf16x8 pa0,bf16x8 pa1,bf16x8 pa2,bf16x8 pa3){
  #pragma unroll
  for(int d0=0;d0<2;++d0){s16x4 lo[4],hi[4];
    #pragma unroll
    for(int ks=0;ks<4;++ks){
      asm volatile("ds_read_b64_tr_b16 %0,%1 offset:%c2":"=&v"(lo[ks]):"v"(vb),"i"(d0*4096+ks*1024):"memory");
      asm volatile("ds_read_b64_tr_b16 %0,%1 offset:%c2":"=&v"(hi[ks]):"v"(vb),"i"(d0*4096+ks*1024+512):"memory");}
    asm volatile("s_waitcnt lgkmcnt(0)":::"memory");SBAR();
    #define PK(k) (bf16x8){lo[k][0],lo[k][1],lo[k][2],lo[k][3],hi[k][0],hi[k][1],hi[k][2],hi[k][3]}
    o[d0]=__builtin_amdgcn_mfma_f32_32x32x16_bf16(pa0,PK(0),o[d0],0,0,0);
    o[d0]=__builtin_amdgcn_mfma_f32_32x32x16_bf16(pa1,PK(1),o[d0],0,0,0);
    o[d0]=__builtin_amdgcn_mfma_f32_32x32x16_bf16(pa2,PK(2),o[d0],0,0,0);
    o[d0]=__builtin_amdgcn_mfma_f32_32x32x16_bf16(pa3,PK(3),o[d0],0,0,0);
    #undef PK
  }
}

#ifndef ATTN_STORE16
#define ATTN_STORE16(p,v) (*(u32x4*)(p)=(v))
#endif
template<int MODE,int THRL,int qstride,int kvstride,int ostride,int lsestride> __device__ __forceinline__ void attn_unit(const bf16*Q0,const bf16*__restrict__ K0,const bf16*__restrict__ V0,bf16*O0,float*lsep,const int NT,const int joff,char*shm){
  int tid=threadIdx.x; asm volatile("":"+v"(tid)); const int lane=tid&63,r32=lane&31,hi=lane>>5; const int wid=__builtin_amdgcn_readfirstlane(tid>>6);
  const bf16*Qw=Q0+(wid*QBLK)*qstride;
  const bf16*Kh=K0,*Vh=V0;
  const unsigned lds0=(unsigned)(uintptr_t)shm;
  float*wsf=(float*)(shm+LDS_WS)+wid*64;
  const unsigned kvo=(unsigned)(lane*kvstride+wid*8)*2u;
  const unsigned vvo=(unsigned)((16*(wid&3)+(lane>>2))*kvstride+(wid>>2)*32+(lane&3)*8)*2u;
  const unsigned kdst=lds0+LDS_K+wid*1024, vdst=lds0+LDS_V+wid*1024;
  #define DMA_K(t,slot) glds16(Kh+(t)*KVBLK*kvstride,kvo,(unsigned)__builtin_amdgcn_readfirstlane(kdst+(slot)))
  #define DMA_V(t,slot) glds16(Vh+(t)*KVBLK*kvstride,vvo,(unsigned)__builtin_amdgcn_readfirstlane(vdst+(slot)))
  const int vb0=(int)(lds0+LDS_V)+((lane>>4)&1)*32+(lane&3)*8+(4*hi+((lane&15)>>2))*64;
  const char*Kbase=shm+LDS_K; bf16x8 kf[8];
  const lds_cptr shm3=(lds_cptr)shm; const lds_cptr kp0=shm3+LDS_K+hi*1024+r32*16; const lds_cptr vp0=shm3+LDS_V+((lane>>4)&1)*32+(lane&3)*8+(4*hi+((lane&15)>>2))*64;
  DMA_K(0,0);DMA_V(0,0);DMA_K(1,SLOTB);
  bf16x8 qr[4];
  #pragma unroll
  for(int d0=0;d0<4;++d0)qr[d0]=*reinterpret_cast<const bf16x8*>(&Qw[r32*qstride+d0*16+hi*8]);
  float mhat=0.f,l_reg=0.f;f32x16 o[2];o[0]=f32x16{};o[1]=f32x16{};f32x16 negm=f32x16{};asm volatile("":"+v"(negm));
  const int qrel=wid*QBLK+r32;
  #define CMASK(P0,P1,t) amask<MODE>(P0,P1,(t),NT,joff,qrel,hi)
  bool resc=false;
  #define START(P0,P1) do{ const float rm=rowmax(P0,P1); resc=false; \
    { const float dl=(MODE==1&&rm<-1e30f)?0.f:rm; mhat=fadd_s(mhat,dl); \
      _Pragma("unroll") for(int r=0;r<16;++r){P0[r]=fsub_s(P0[r],dl);P1[r]=fsub_s(P1[r],dl);} \
      _Pragma("unroll") for(int r=0;r<16;++r)negm[r]=-mhat; asm volatile("":"+v"(negm)); } \
    _Pragma("unroll") for(int r=0;r<16;++r)P0[r]=__builtin_amdgcn_exp2f(P0[r]); }while(0)
  #define RESC() do{ if(resc){ asm volatile("s_waitcnt lgkmcnt(0)":::"memory"); \
      _Pragma("unroll") for(int d_=0;d_<2;++d_) _Pragma("unroll") for(int r=0;r<16;++r)o[d_][r]*=wsf[crow(r,hi)]; } }while(0)
  f32x16 pA0,pA1,pB0,pB1;
  int sl_prev=0,sl_cur=0,sl_next=SLOTB;
  #define ROT() do{sl_prev=sl_cur;sl_cur=sl_next;sl_next=(sl_next==(NSLOT-1)*SLOTB)?0:sl_next+SLOTB;}while(0)
  DMA_K(2,2*SLOTB);
  WAIT_BAR(3);
  const int t_lo_=(wid>>1)-joff, t_lo=(MODE==1)?(t_lo_<0?0:t_lo_):0, t_hi=(MODE==1)?(t_lo_+2):(NT-1);
  if(t_lo==0){
    qkt(pA0,pA1,Kbase,qr,negm,r32,hi);asm volatile("s_nop 15\n\ts_nop 7":"+v"(pA0),"+v"(pA1));CMASK(pA0,pA1,0);
    START(pA0,pA1);
    _Pragma("unroll") for(int r=0;r<16;++r)pA1[r]=__builtin_amdgcn_exp2f(pA1[r]);
  }
  WAIT_BAR(0);
  DMA_K(3,0);DMA_V(1,SLOTB);
  ROT();
  if(t_lo<=1&&1<=t_hi)kload8(kf,kp0+sl_cur);
  WAIT_BAR(2);
  s16x4 vlo[8],vhi[8]; u32x4 pw0,pw1,pw2,pw3;
  #define PKW(P,B) cvtpk_s(P[B],P[B+1])
  #define PAF(k) __builtin_bit_cast(bf16x8,pw##k)
  #define VFR(i) (bf16x8){vlo[i][0],vlo[i][1],vlo[i][2],vlo[i][3],vhi[i][0],vhi[i][1],vhi[i][2],vhi[i][3]}
  #define PIN(x) asm volatile("":"+v"(x))
  #define MX3(a,b,c) __builtin_fmaxf(__builtin_fmaxf((a),(b)),(c))
  #define GAPA(MF,A0,A1,A2,A3,W0,W1,PW) do{ MF; sacc+=A0; sacc+=A1; sacc+=A2; sacc+=A3; PIN(sacc); W0; W1; PIN(PW); SBAR(); }while(0)
  #define EX(v) __builtin_amdgcn_exp2f(v)
  #define GAPB(MF,X,B) do{ MF; X[B]=EX(X[B]); X[B+1]=EX(X[B+1]); X[B+2]=EX(X[B+2]); X[B+3]=EX(X[B+3]); PIN(X); SBAR(); }while(0)
  #define VRD(i) do{ vlo[i]=vtr(vp_+(((i)>>2)*4096+((i)&3)*1024)); vhi[i]=vtr(vp_+(((i)>>2)*4096+((i)&3)*1024+512)); }while(0)
  #define KRD(G,j) do{ if(G){ kload2(kf,kp0+sl_next,j); SBAR(); } }while(0)
  #define STEP(C0,C1,P0,P1,t,GK,GV,GL) do{ SBAR(); \
    const lds_cptr vp_=vp0+sl_prev; \
    VRD(0); SBAR(); float sacc=(P0[0]+P0[1]); \
    GAPA(C0=__builtin_amdgcn_mfma_f32_32x32x16_bf16(kf[0],qr[0],negm,0,0,0), P0[2],P0[3],P0[4],P0[5],     pw0[0]=PKW(P0,0), pw0[1]=PKW(P0,2), pw0); \
    VRD(4); SBAR(); GAPA(C1=__builtin_amdgcn_mfma_f32_32x32x16_bf16(kf[1],qr[0],negm,0,0,0), P0[6],P0[7],P0[8],P0[9],     pw0[2]=PKW(P0,4), pw0[3]=PKW(P0,6), pw0); \
    VRD(1); SBAR(); GAPA(C0=__builtin_amdgcn_mfma_f32_32x32x16_bf16(kf[2],qr[1],C0,0,0,0),   P0[10],P0[11],P0[12],P0[13], pw1[0]=PKW(P0,8), pw1[1]=PKW(P0,10), pw1); \
    VRD(5); SBAR(); GAPA(C1=__builtin_amdgcn_mfma_f32_32x32x16_bf16(kf[3],qr[1],C1,0,0,0),   P0[14],P0[15],P1[0],P1[1],   pw1[2]=PKW(P0,12),pw1[3]=PKW(P0,14), pw1); \
    VRD(2); SBAR(); GAPA(C0=__builtin_amdgcn_mfma_f32_32x32x16_bf16(kf[4],qr[2],C0,0,0,0),   P1[2],P1[3],P1[4],P1[5],     pw2[0]=PKW(P1,0), pw2[1]=PKW(P1,2), pw2); \
    VRD(6); SBAR(); GAPA(C1=__builtin_amdgcn_mfma_f32_32x32x16_bf16(kf[5],qr[2],C1,0,0,0),   P1[6],P1[7],P1[8],P1[9],     pw2[2]=PKW(P1,4), pw2[3]=PKW(P1,6), pw2); \
    VRD(3); SBAR(); GAPA(C0=__builtin_amdgcn_mfma_f32_32x32x16_bf16(kf[6],qr[3],C0,0,0,0),   P1[10],P1[11],P1[12],P1[13], pw3[0]=PKW(P1,8), pw3[1]=PKW(P1,10), pw3); \
    VRD(7); SBAR(); GAPA(C1=__builtin_amdgcn_mfma_f32_32x32x16_bf16(kf[7],qr[3],C1,0,0,0),   P1[14],P1[15],0.f,0.f,       pw3[2]=PKW(P1,12),pw3[3]=PKW(P1,14), pw3); \
    l_reg+=sacc; \
    if(GK){DMA_K((t)+3,sl_cur);} if(GV){DMA_V((t)+1,sl_next);} \
    CMASK(C0,C1,t); \
    { float a=MX3(C0[0],C0[1],C1[0]),b=MX3(C0[2],C0[3],C1[1]); a=MX3(a,C1[2],C1[3]); \
      _Pragma("unroll") for(int r=4;r<16;r+=4){a=MX3(a,C0[r],C0[r+1]);b=MX3(b,C0[r+2],C0[r+3]);a=MX3(a,C1[r],C1[r+1]);b=MX3(b,C1[r+2],C1[r+3]);} \
      float rm=__builtin_fmaxf(a,b); { auto rr=__builtin_amdgcn_permlane32_swap(__float_as_uint(rm),__float_as_uint(rm),false,false); rm=__builtin_fmaxf(__uint_as_float(rr[0]),__uint_as_float(rr[1])); } \
      resc=false; \
      if(__builtin_expect(__any(rm>(float)THRL),0)){ const float dl=__builtin_fmaxf(rm,0.f); mhat+=dl; \
        _Pragma("unroll") for(int r=0;r<16;++r){C0[r]-=dl;C1[r]-=dl;} \
        _Pragma("unroll") for(int r=0;r<16;++r)negm[r]=-mhat; asm volatile("":"+v"(negm)); \
        const float f=__builtin_amdgcn_exp2f(-dl); l_reg*=f; if(hi==0)wsf[r32]=f; resc=true; } } \
    SBAR(); \
    GAPB(o[0]=__builtin_amdgcn_mfma_f32_32x32x16_bf16(PAF(0),VFR(0),o[0],0,0,0), C0,0); \
    GAPB(o[1]=__builtin_amdgcn_mfma_f32_32x32x16_bf16(PAF(0),VFR(4),o[1],0,0,0), C0,4); \
    KRD(GL,0); GAPB(o[0]=__builtin_amdgcn_mfma_f32_32x32x16_bf16(PAF(1),VFR(1),o[0],0,0,0), C0,8); \
    KRD(GL,1); GAPB(o[1]=__builtin_amdgcn_mfma_f32_32x32x16_bf16(PAF(1),VFR(5),o[1],0,0,0), C0,12); \
    KRD(GL,2); GAPB(o[0]=__builtin_amdgcn_mfma_f32_32x32x16_bf16(PAF(2),VFR(2),o[0],0,0,0), C1,0); \
    KRD(GL,3); GAPB(o[1]=__builtin_amdgcn_mfma_f32_32x32x16_bf16(PAF(2),VFR(6),o[1],0,0,0), C1,4); \
    GAPB(o[0]=__builtin_amdgcn_mfma_f32_32x32x16_bf16(PAF(3),VFR(3),o[0],0,0,0), C1,8); \
    GAPB(o[1]=__builtin_amdgcn_mfma_f32_32x32x16_bf16(PAF(3),VFR(7),o[1],0,0,0), C1,12); \
    }while(0)
  #define ENDW(tt) do{ if((tt)+3<NT){WAIT_BAR(2);} else if((tt)+2<NT){WAIT_BAR(1);} else {WAIT_BAR(0);} }while(0)
  #define PVONLY(P0,P1,slot) do{ float sacc=P0[0]+P0[1]; _Pragma("unroll") for(int r=2;r<16;++r)sacc+=P0[r]; _Pragma("unroll") for(int r=0;r<16;++r)sacc+=P1[r]; l_reg+=sacc; \
    pw0=(u32x4){PKW(P0,0),PKW(P0,2),PKW(P0,4),PKW(P0,6)};pw1=(u32x4){PKW(P0,8),PKW(P0,10),PKW(P0,12),PKW(P0,14)};pw2=(u32x4){PKW(P1,0),PKW(P1,2),PKW(P1,4),PKW(P1,6)};pw3=(u32x4){PKW(P1,8),PKW(P1,10),PKW(P1,12),PKW(P1,14)}; \
    SBAR(); pv(o,vb0+(slot),PAF(0),PAF(1),PAF(2),PAF(3)); }while(0)
  if constexpr(MODE==0){
  int t=1;
  #undef CMASK
  #define CMASK(P0,P1,t) do{}while(0)
  for(;t+5<NT;t+=2){
    STEP(pB0,pB1,pA0,pA1,t,true,true,true);     WAIT_BAR(2); RESC(); ROT();
    STEP(pA0,pA1,pB0,pB1,t+1,true,true,true);   WAIT_BAR(2); RESC(); ROT();
  }
  #undef CMASK
  #define CMASK(P0,P1,t) amask<MODE>(P0,P1,(t),NT,joff,qrel,hi)
  for(;t+1<NT;t+=2){
    STEP(pB0,pB1,pA0,pA1,t,(t+3<NT),(t+1<NT),(t+1<NT));       ENDW(t);   RESC(); ROT();
    STEP(pA0,pA1,pB0,pB1,t+1,(t+4<NT),(t+2<NT),(t+2<NT));     ENDW(t+1); RESC(); ROT();
  }
  STEP(pB0,pB1,pA0,pA1,NT-1,false,false,false); RESC();
  PVONLY(pB0,pB1,sl_cur);
  } else {
  #define QK8(C0,C1) do{ \
    C0=__builtin_amdgcn_mfma_f32_32x32x16_bf16(kf[0],qr[0],negm,0,0,0);C1=__builtin_amdgcn_mfma_f32_32x32x16_bf16(kf[1],qr[0],negm,0,0,0); \
    C0=__builtin_amdgcn_mfma_f32_32x32x16_bf16(kf[2],qr[1],C0,0,0,0);C1=__builtin_amdgcn_mfma_f32_32x32x16_bf16(kf[3],qr[1],C1,0,0,0); \
    C0=__builtin_amdgcn_mfma_f32_32x32x16_bf16(kf[4],qr[2],C0,0,0,0);C1=__builtin_amdgcn_mfma_f32_32x32x16_bf16(kf[5],qr[2],C1,0,0,0); \
    C0=__builtin_amdgcn_mfma_f32_32x32x16_bf16(kf[6],qr[3],C0,0,0,0);C1=__builtin_amdgcn_mfma_f32_32x32x16_bf16(kf[7],qr[3],C1,0,0,0); \
    asm volatile("s_nop 15\n\ts_nop 7":"+v"(C0),"+v"(C1)); }while(0)
  #define QKONLY(C0,C1,s) do{ QK8(C0,C1); CMASK(C0,C1,s); START(C0,C1); \
    _Pragma("unroll") for(int r=0;r<16;++r)C1[r]=__builtin_amdgcn_exp2f(C1[r]); }while(0)
  #define QKNEXT(C0,C1,s) do{ QK8(C0,C1); CMASK(C0,C1,s); \
    { float rm=rowmax(C0,C1); \
      if(__builtin_expect(__any(rm>(float)THRL),0)){ const float dl=__builtin_fmaxf(rm,0.f); mhat+=dl; \
        _Pragma("unroll") for(int r=0;r<16;++r){C0[r]-=dl;C1[r]-=dl;} \
        _Pragma("unroll") for(int r=0;r<16;++r)negm[r]=-mhat; asm volatile("":"+v"(negm)); \
        const float f=__builtin_amdgcn_exp2f(-dl); l_reg*=f; if(hi==0)wsf[r32]=f; resc=true; } } \
    _Pragma("unroll") for(int r=0;r<16;++r){C0[r]=__builtin_amdgcn_exp2f(C0[r]);C1[r]=__builtin_amdgcn_exp2f(C1[r]);} }while(0)
  for(int s=1;s<NT;++s){
    const bool qk_=(t_lo<=s)&&(s<=t_hi), pv_=(t_lo<=s-1)&&(s-1<=t_hi), kn_=(t_lo<=s+1)&&(s+1<=t_hi); resc=false;
    if(pv_){ PVONLY(pA0,pA1,sl_prev); }
    if(qk_){ if(s==t_lo){ QKONLY(pA0,pA1,s); } else { QKNEXT(pA0,pA1,s); } }
    if(s+3<NT){DMA_K(s+3,sl_cur);} if(s+1<NT){DMA_V(s+1,sl_next);}
    if(kn_){ kload8(kf,kp0+sl_next); }
    ENDW(s); RESC(); ROT();
  }
  if(t_hi==NT-1){ PVONLY(pA0,pA1,sl_prev); }
  #undef QK8
  #undef QKNEXT
  #undef QKONLY
  }
  #undef PVONLY
  #undef PKW
  #undef PAF
  #undef VFR
  #undef PIN
  #undef MX3
  #undef GAPA
  #undef GAPB
  #undef EX
  #undef VRD
  #undef KRD
  #undef STEP
  #undef ENDW
  {auto rr=__builtin_amdgcn_permlane32_swap(__float_as_uint(l_reg),__float_as_uint(l_reg),false,false);l_reg=__uint_as_float(rr[0])+__uint_as_float(rr[1]);}
  if(hi==0){wsf[32+r32]=l_reg; if(lsep)lsep[(wid*QBLK+r32)*lsestride]=mhat+__builtin_amdgcn_logf(l_reg);}asm volatile("s_waitcnt lgkmcnt(0)":::"memory");
  float rli[16];
  #pragma unroll
  for(int r=0;r<16;++r)rli[r]=__builtin_amdgcn_rcpf(wsf[32+crow(r,hi)]);
  bf16*Ow=O0+(wid*QBLK)*ostride;
  { bf16*stg=(bf16*)(shm+LDS_OST)+wid*2048;
    #pragma unroll
    for(int r=0;r<16;++r){const int orow=crow(r,hi);
      #pragma unroll
      for(int d0=0;d0<2;++d0)stg[orow*64+d0*32+r32]=__float2bfloat16(o[d0][r]*rli[r]);}
    asm volatile("s_waitcnt lgkmcnt(0)":::"memory");
    #pragma unroll
    for(int i=0;i<4;++i){const int row=i*8+(lane>>3),ch=lane&7; const u32x4 v=*(const u32x4*)(stg+row*64+ch*8); ATTN_STORE16(Ow+row*ostride+ch*8,v);} }
  asm volatile("s_waitcnt lgkmcnt(0)\n\ts_barrier":::"memory");
  #undef DMA_K
  #undef DMA_V
  #undef CMASK
  #undef START
  #undef RESC
  #undef ROT
}
constexpr int VSLOTB=16384, LDS2_K=0, LDS2_V=NSLOT*SLOTB, LDS2_WS=LDS2_V+NSLOT*VSLOTB, LDS2_OST=LDS2_WS+NW*64*4, LDS2_BYTES=LDS2_OST+NW*4096;
__device__ __forceinline__ f32x2_t pk_sub(f32x2_t a,f32x2_t b){f32x2_t r;asm("v_pk_add_f32 %0, %1, %2 neg_lo:[0,1] neg_hi:[0,1]":"=v"(r):"v"(a),"v"(b));return r;}
__device__ __forceinline__ f32x2_t pk_add(f32x2_t a,f32x2_t b){f32x2_t r;asm("v_pk_add_f32 %0, %1, %2":"=v"(r):"v"(a),"v"(b));return r;}
template<int THRL,int qstride,int kvstride,int ostride> __device__ __forceinline__ void attn_unit128(const bf16*Q0,const bf16*__restrict__ K0,const bf16*__restrict__ V0,bf16*O0,const int NT,char*shm){
  int tid=threadIdx.x; asm volatile("":"+v"(tid)); const int lane=tid&63,r32=lane&31,hi=lane>>5; const int wid=__builtin_amdgcn_readfirstlane(tid>>6);
  const bf16*Qw=Q0+(wid*QBLK)*qstride;
  const bf16*Kh=K0,*Vh=V0;
  const unsigned lds0=(unsigned)(uintptr_t)shm;
  float*wsf=(float*)(shm+LDS2_WS)+wid*64;
  const unsigned kvo=(unsigned)(lane*kvstride+wid*8)*2u;
  const unsigned vvo=(unsigned)((16*(wid&3)+(lane>>2))*kvstride+(wid>>2)*32+(lane&3)*8)*2u;
  const unsigned kdst=lds0+LDS2_K+wid*1024, vdst=lds0+LDS2_V+wid*1024;
  #define DMA_K(t,slot) glds16(Kh+(t)*KVBLK*kvstride,kvo,(unsigned)__builtin_amdgcn_readfirstlane(kdst+(slot)))
  #define DMA_V(t,slot) do{ glds16(Vh+(t)*KVBLK*kvstride,vvo,(unsigned)__builtin_amdgcn_readfirstlane(vdst+2*(slot))); glds16(Vh+(t)*KVBLK*kvstride+64,vvo,(unsigned)__builtin_amdgcn_readfirstlane(vdst+2*(slot)+8192)); }while(0)
  const int vb0=(int)(lds0+LDS2_V)+((lane>>4)&1)*32+(lane&3)*8+(4*hi+((lane&15)>>2))*64;
  bf16x8 kf[8];
  const lds_cptr shm3=(lds_cptr)shm; const lds_cptr kp0=shm3+LDS2_K+hi*1024+r32*16; const lds_cptr vp0=shm3+LDS2_V+((lane>>4)&1)*32+(lane&3)*8+(4*hi+((lane&15)>>2))*64;
  DMA_K(0,0);DMA_V(0,0);DMA_K(1,SLOTB);
  bf16x8 qr[4];
  #pragma unroll
  for(int d0=0;d0<4;++d0)qr[d0]=*reinterpret_cast<const bf16x8*>(&Qw[r32*qstride+d0*16+hi*8]);
  float mhat=0.f,l_reg=0.f;f32x16 o[4];o[0]=f32x16{};o[1]=f32x16{};o[2]=f32x16{};o[3]=f32x16{};
  const int qrel=wid*QBLK+r32;
  #define BFR(x) __uint_as_float(cvtpk_s((x),0.f)<<16)
  const bf16x8 kone=(bf16x8){(short)(hi==0?0x3F80:0),0,0,0,0,0,0,0};
  bf16x8 qm=(bf16x8){0,0,0,0,0,0,0,0};
  #define SETQM() do{ const short mb_=(short)(cvtpk_s(-mhat,0.f)&0xffffu); qm[0]=(hi==0)?mb_:(short)0; }while(0)
  #define CMASK(P0,P1,t) amask<0>(P0,P1,(t),NT,0,qrel,hi)
  bool resc=false;
  #define RESC() do{ if(resc){ asm volatile("s_waitcnt lgkmcnt(0)":::"memory"); \
      _Pragma("unroll") for(int r=0;r<16;++r){ const float f_=wsf[crow(r,hi)]; o[0][r]*=f_; o[1][r]*=f_; o[2][r]*=f_; o[3][r]*=f_; } } }while(0)
  f32x16 pA0,pA1,pB0,pB1;
  int sl_prev=0,sl_cur=0,sl_next=SLOTB;
  #define ROT() do{sl_prev=sl_cur;sl_cur=sl_next;sl_next=(sl_next==(NSLOT-1)*SLOTB)?0:sl_next+SLOTB;}while(0)
  DMA_K(2,2*SLOTB);
  WAIT_BAR(4);
  { kload8(kf,kp0);
    const f32x16 z=f32x16{};
    pA0=__builtin_amdgcn_mfma_f32_32x32x16_bf16(kf[0],qr[0],z,0,0,0);pA1=__builtin_amdgcn_mfma_f32_32x32x16_bf16(kf[1],qr[0],z,0,0,0);
    pA0=__builtin_amdgcn_mfma_f32_32x32x16_bf16(kf[2],qr[1],pA0,0,0,0);pA1=__builtin_amdgcn_mfma_f32_32x32x16_bf16(kf[3],qr[1],pA1,0,0,0);
    pA0=__builtin_amdgcn_mfma_f32_32x32x16_bf16(kf[4],qr[2],pA0,0,0,0);pA1=__builtin_amdgcn_mfma_f32_32x32x16_bf16(kf[5],qr[2],pA1,0,0,0);
    pA0=__builtin_amdgcn_mfma_f32_32x32x16_bf16(kf[6],qr[3],pA0,0,0,0);pA1=__builtin_amdgcn_mfma_f32_32x32x16_bf16(kf[7],qr[3],pA1,0,0,0); }
  asm volatile("s_nop 15\n\ts_nop 7":"+v"(pA0),"+v"(pA1));CMASK(pA0,pA1,0);
  { const float rm=rowmax(pA0,pA1); mhat=BFR(rm);
    _Pragma("unroll") for(int r=0;r<16;++r){pA0[r]=__builtin_amdgcn_exp2f(pA0[r]-mhat);pA1[r]=__builtin_amdgcn_exp2f(pA1[r]-mhat);} SETQM(); }
  WAIT_BAR(0);
  DMA_K(3,0);DMA_V(1,SLOTB);
  ROT();
  kload8(kf,kp0+sl_cur);
  WAIT_BAR(3);
  s16x4 vlo[8],vhi[8]; u32x4 pw0,pw1,pw2,pw3;
  #define PKW(P,B) cvtpk_s(P[B],P[B+1])
  #define PAF(k) __builtin_bit_cast(bf16x8,pw##k)
  #define VFR(i) (bf16x8){vlo[i][0],vlo[i][1],vlo[i][2],vlo[i][3],vhi[i][0],vhi[i][1],vhi[i][2],vhi[i][3]}
  #define PIN(x) asm volatile("":"+v"(x))
  #define MX3(a,b,c) __builtin_fmaxf(__builtin_fmaxf((a),(b)),(c))
  #define GAPA(MF,A0,A1,A2,A3,W0,W1,PW) do{ MF; sacc+=A0; sacc+=A1; sacc+=A2; sacc+=A3; PIN(sacc); W0; W1; PIN(PW); SBAR(); }while(0)
  #define EX(v) __builtin_amdgcn_exp2f(v)
  #define GAPB(MF,X,B) do{ MF; X[B]=EX(X[B]); X[B+1]=EX(X[B+1]); PIN(X); SBAR(); }while(0)
  #define VRD(i) do{ vlo[i]=vtr(vp_+(((i)>>2)*4096+((i)&3)*1024)); vhi[i]=vtr(vp_+(((i)>>2)*4096+((i)&3)*1024+512)); }while(0)
  #define VRD2(i) do{ vlo[i]=vtr(vp_+(8192+((i)>>2)*4096+((i)&3)*1024)); vhi[i]=vtr(vp_+(8192+((i)>>2)*4096+((i)&3)*1024+512)); SBAR(); }while(0)
  #define KRD(G,j) do{ if(G){ kload2(kf,kp0+sl_next,j); SBAR(); } }while(0)
  #define ZC (f32x16{})
  #define STEP(C0,C1,P0,P1,t,GK,GV,GL) do{ SBAR(); \
    const lds_cptr vp_=vp0+2*sl_prev; \
    C0=__builtin_amdgcn_mfma_f32_32x32x16_bf16(kone,qm,ZC,0,0,0); C1=__builtin_amdgcn_mfma_f32_32x32x16_bf16(kone,qm,ZC,0,0,0); SBAR(); \
    VRD(0); SBAR(); float sacc=(P0[0]+P0[1]); \
    GAPA(C0=__builtin_amdgcn_mfma_f32_32x32x16_bf16(kf[0],qr[0],C0,0,0,0), P0[2],P0[3],P0[4],P0[5],     pw0[0]=PKW(P0,0), pw0[1]=PKW(P0,2), pw0); \
    VRD(4); SBAR(); GAPA(C1=__builtin_amdgcn_mfma_f32_32x32x16_bf16(kf[1],qr[0],C1,0,0,0), P0[6],P0[7],P0[8],P0[9],     pw0[2]=PKW(P0,4), pw0[3]=PKW(P0,6), pw0); \
    VRD(1); SBAR(); GAPA(C0=__builtin_amdgcn_mfma_f32_32x32x16_bf16(kf[2],qr[1],C0,0,0,0),   P0[10],P0[11],P0[12],P0[13], pw1[0]=PKW(P0,8), pw1[1]=PKW(P0,10), pw1); \
    VRD(5); SBAR(); GAPA(C1=__builtin_amdgcn_mfma_f32_32x32x16_bf16(kf[3],qr[1],C1,0,0,0),   P0[14],P0[15],P1[0],P1[1],   pw1[2]=PKW(P0,12),pw1[3]=PKW(P0,14), pw1); \
    VRD(2); SBAR(); GAPA(C0=__builtin_amdgcn_mfma_f32_32x32x16_bf16(kf[4],qr[2],C0,0,0,0),   P1[2],P1[3],P1[4],P1[5],     pw2[0]=PKW(P1,0), pw2[1]=PKW(P1,2), pw2); \
    VRD(6); SBAR(); GAPA(C1=__builtin_amdgcn_mfma_f32_32x32x16_bf16(kf[5],qr[2],C1,0,0,0),   P1[6],P1[7],P1[8],P1[9],     pw2[2]=PKW(P1,4), pw2[3]=PKW(P1,6), pw2); \
    VRD(3); SBAR(); GAPA(C0=__builtin_amdgcn_mfma_f32_32x32x16_bf16(kf[6],qr[3],C0,0,0,0),   P1[10],P1[11],P1[12],P1[13], pw3[0]=PKW(P1,8), pw3[1]=PKW(P1,10), pw3); \
    VRD(7); SBAR(); GAPA(C1=__builtin_amdgcn_mfma_f32_32x32x16_bf16(kf[7],qr[3],C1,0,0,0),   P1[14],P1[15],0.f,0.f,       pw3[2]=PKW(P1,12),pw3[3]=PKW(P1,14), pw3); \
    l_reg+=sacc; \
    if(GK){DMA_K((t)+3,sl_cur);} if(GV){DMA_V((t)+1,sl_next);} \
    CMASK(C0,C1,t); \
    { float a=MX3(C0[0],C0[1],C1[0]),b=MX3(C0[2],C0[3],C1[1]); a=MX3(a,C1[2],C1[3]); \
      _Pragma("unroll") for(int r=4;r<16;r+=4){a=MX3(a,C0[r],C0[r+1]);b=MX3(b,C0[r+2],C0[r+3]);a=MX3(a,C1[r],C1[r+1]);b=MX3(b,C1[r+2],C1[r+3]);} \
      float rm=__builtin_fmaxf(a,b); { auto rr=__builtin_amdgcn_permlane32_swap(__float_as_uint(rm),__float_as_uint(rm),false,false); rm=__builtin_fmaxf(__uint_as_float(rr[0]),__uint_as_float(rr[1])); } \
      resc=false; \
      if(__builtin_expect(__any(rm>(float)THRL),0)){ const float mn_=BFR(mhat+__builtin_fmaxf(rm,0.f)); const float dl=mn_-mhat; mhat=mn_; SETQM(); \
        _Pragma("unroll") for(int r=0;r<16;++r){C0[r]-=dl;C1[r]-=dl;} \
        const float f=__builtin_amdgcn_exp2f(-dl); l_reg*=f; if(hi==0)wsf[r32]=f; resc=true; } } \
    SBAR(); \
    GAPB(o[0]=__builtin_amdgcn_mfma_f32_32x32x16_bf16(PAF(0),VFR(0),o[0],0,0,0), C0,0);  VRD2(0); \
    GAPB(o[1]=__builtin_amdgcn_mfma_f32_32x32x16_bf16(PAF(0),VFR(4),o[1],0,0,0), C0,2);  VRD2(4); \
    GAPB(o[0]=__builtin_amdgcn_mfma_f32_32x32x16_bf16(PAF(1),VFR(1),o[0],0,0,0), C0,4);  VRD2(1); \
    GAPB(o[1]=__builtin_amdgcn_mfma_f32_32x32x16_bf16(PAF(1),VFR(5),o[1],0,0,0), C0,6);  VRD2(5); \
    GAPB(o[0]=__builtin_amdgcn_mfma_f32_32x32x16_bf16(PAF(2),VFR(2),o[0],0,0,0), C0,8);  VRD2(2); \
    GAPB(o[1]=__builtin_amdgcn_mfma_f32_32x32x16_bf16(PAF(2),VFR(6),o[1],0,0,0), C0,10); VRD2(6); \
    GAPB(o[0]=__builtin_amdgcn_mfma_f32_32x32x16_bf16(PAF(3),VFR(3),o[0],0,0,0), C0,12); VRD2(3); \
    GAPB(o[1]=__builtin_amdgcn_mfma_f32_32x32x16_bf16(PAF(3),VFR(7),o[1],0,0,0), C0,14); VRD2(7); \
    GAPB(o[2]=__builtin_amdgcn_mfma_f32_32x32x16_bf16(PAF(0),VFR(0),o[2],0,0,0), C1,0); \
    GAPB(o[3]=__builtin_amdgcn_mfma_f32_32x32x16_bf16(PAF(0),VFR(4),o[3],0,0,0), C1,2); \
    KRD(GL,0); GAPB(o[2]=__builtin_amdgcn_mfma_f32_32x32x16_bf16(PAF(1),VFR(1),o[2],0,0,0), C1,4); \
    KRD(GL,1); GAPB(o[3]=__builtin_amdgcn_mfma_f32_32x32x16_bf16(PAF(1),VFR(5),o[3],0,0,0), C1,6); \
    KRD(GL,2); GAPB(o[2]=__builtin_amdgcn_mfma_f32_32x32x16_bf16(PAF(2),VFR(2),o[2],0,0,0), C1,8); \
    KRD(GL,3); GAPB(o[3]=__builtin_amdgcn_mfma_f32_32x32x16_bf16(PAF(2),VFR(6),o[3],0,0,0), C1,10); \
    GAPB(o[2]=__builtin_amdgcn_mfma_f32_32x32x16_bf16(PAF(3),VFR(3),o[2],0,0,0), C1,12); \
    GAPB(o[3]=__builtin_amdgcn_mfma_f32_32x32x16_bf16(PAF(3),VFR(7),o[3],0,0,0), C1,14); \
    }while(0)
  int t=1;
  #undef CMASK
  #define CMASK(P0,P1,t) do{}while(0)
  for(;t+5<NT;t+=2){
    STEP(pB0,pB1,pA0,pA1,t,true,true,true);     WAIT_BAR(3); RESC(); ROT();
    STEP(pA0,pA1,pB0,pB1,t+1,true,true,true);   WAIT_BAR(3); RESC(); ROT();
  }
  #undef CMASK
  #define CMASK(P0,P1,t) amask<0>(P0,P1,(t),NT,0,qrel,hi)
  #define ENDW(tt) do{ if((tt)+3<NT){WAIT_BAR(3);} else if((tt)+2<NT){WAIT_BAR(2);} else {WAIT_BAR(0);} }while(0)
  for(;t+1<NT;t+=2){
    STEP(pB0,pB1,pA0,pA1,t,(t+3<NT),(t+1<NT),(t+1<NT));       ENDW(t);   RESC(); ROT();
    STEP(pA0,pA1,pB0,pB1,t+1,(t+4<NT),(t+2<NT),(t+2<NT));     ENDW(t+1); RESC(); ROT();
  }
  STEP(pB0,pB1,pA0,pA1,NT-1,false,false,false); RESC();
  { float sacc=pB0[0]+pB0[1]; _Pragma("unroll") for(int r=2;r<16;++r)sacc+=pB0[r]; _Pragma("unroll") for(int r=0;r<16;++r)sacc+=pB1[r]; l_reg+=sacc;
    pw0=(u32x4){PKW(pB0,0),PKW(pB0,2),PKW(pB0,4),PKW(pB0,6)};pw1=(u32x4){PKW(pB0,8),PKW(pB0,10),PKW(pB0,12),PKW(pB0,14)};pw2=(u32x4){PKW(pB1,0),PKW(pB1,2),PKW(pB1,4),PKW(pB1,6)};pw3=(u32x4){PKW(pB1,8),PKW(pB1,10),PKW(pB1,12),PKW(pB1,14)};
    SBAR(); pv(o,vb0+2*sl_cur,PAF(0),PAF(1),PAF(2),PAF(3)); SBAR(); pv(o+2,vb0+2*sl_cur+8192,PAF(0),PAF(1),PAF(2),PAF(3)); }
  #undef PKW
  #undef PAF
  #undef VFR
  #undef PIN
  #undef MX3
  #undef GAPA
  #undef GAPB
  #undef EX
  #undef VRD
  #undef VRD2
  #undef KRD
  #undef ZC
  #undef BFR
  #undef SETQM
  #undef STEP
  #undef ENDW
  {auto rr=__builtin_amdgcn_permlane32_swap(__float_as_uint(l_reg),__float_as_uint(l_reg),false,false);l_reg=__uint_as_float(rr[0])+__uint_as_float(rr[1]);}
  if(hi==0){wsf[32+r32]=l_reg;}asm volatile("s_waitcnt lgkmcnt(0)":::"memory");
  float rli[16];
  #pragma unroll
  for(int r=0;r<16;++r)rli[r]=__builtin_amdgcn_rcpf(wsf[32+crow(r,hi)]);
  bf16*Ow=O0+(wid*QBLK)*ostride;
  { bf16*stg=(bf16*)(shm+LDS2_OST)+wid*2048;
    #pragma unroll
    for(int j=0;j<2;++j){
      #pragma unroll
      for(int r=0;r<16;++r){const int orow=crow(r,hi);
        #pragma unroll
        for(int d0=0;d0<2;++d0)stg[orow*64+d0*32+r32]=__float2bfloat16(o[2*j+d0][r]*rli[r]);}
      asm volatile("s_waitcnt lgkmcnt(0)":::"memory");
      #pragma unroll
      for(int i=0;i<4;++i){const int row=i*8+(lane>>3),ch=lane&7; const u32x4 v=*(const u32x4*)(stg+row*64+ch*8); ATTN_STORE16(Ow+row*ostride+j*64+ch*8,v);}
      asm volatile("s_waitcnt lgkmcnt(0)":::"memory"); } }
  asm volatile("s_waitcnt lgkmcnt(0)\n\ts_barrier":::"memory");
  #undef DMA_K
  #undef DMA_V
  #undef CMASK
  #undef RESC
  #undef ROT
}
constexpr int DS_K=0, DS_V=6*8192, DS_WS=12*8192, DS_OST=DS_WS+NW*64*4, DS_BYTES=DS_OST+NW*4096;
struct DswaUnit { const bf16* Q0; const bf16* K0; const bf16* V0; bf16* O0; float* ls; int d; int kmin; int chain; };
__device__ __forceinline__ DswaUnit dswa_desc(int u,const bf16*U,bf16*OA,float*LSE){
  constexpr int UPc=3072, SEQc=8192, Mc=16384;
  const int g=u>>9, rem=u&511, b=rem>>8, h=(rem>>5)&7, w=rem&31;
  const int d=g==0?1:(g==1?4:16), nqb=32/d, r=w/nqb, qb=w%nqb, l0=256*qb;
  const long rb=(long)b*SEQc, pos0=(long)l0*d+r, kpos0=(long)(l0-128)*d+r;
  DswaUnit x; x.Q0=U+(rb+pos0)*UPc+h*64; x.K0=U+(rb+kpos0)*UPc+512+h*64; x.V0=U+(rb+kpos0)*UPc+1024+h*64;
  x.O0=OA+(long)g*Mc*512+(rb+pos0)*512+h*64; x.ls=LSE+(long)g*Mc*8+(rb+pos0)*8+h; x.d=d; x.kmin=qb==0?128:0; x.chain=(rem<511&&qb+1<nqb)?1:0; return x;
}
__device__ __forceinline__ void wait_vm(int n){
  switch(n){ case 0: asm volatile("s_waitcnt vmcnt(0)":::"memory"); break; case 2: asm volatile("s_waitcnt vmcnt(2)":::"memory"); break; case 4: asm volatile("s_waitcnt vmcnt(4)":::"memory"); break;
    case 6: asm volatile("s_waitcnt vmcnt(6)":::"memory"); break; case 8: asm volatile("s_waitcnt vmcnt(8)":::"memory"); break; default: asm volatile("s_waitcnt vmcnt(10)":::"memory"); break; }
}
template<int THRL> __device__ __forceinline__ void dswa_phase(const bf16*U,bf16*OA,float*LSE,const int ubase,const int nunits,char*shm){
  constexpr int UPc=3072;
  int tid=threadIdx.x; asm volatile("":"+v"(tid)); const int lane=tid&63,r32=lane&31,hi=lane>>5; const int wid=__builtin_amdgcn_readfirstlane(tid>>6);
  const unsigned lds0=(unsigned)(uintptr_t)shm;
  float*wsf=(float*)(shm+DS_WS)+wid*64;
  const unsigned kvo1=(unsigned)(lane*UPc)*2u, vvo1=(unsigned)((16*(wid&3)+(lane>>2))*UPc)*2u, kvoc=(unsigned)(wid*8)*2u, vvoc=(unsigned)((wid>>2)*32+(lane&3)*8)*2u;
  const unsigned kdst=lds0+DS_K+wid*1024, vdst=lds0+DS_V+wid*1024;
  const lds_cptr shm3=(lds_cptr)shm; const lds_cptr kp0=shm3+DS_K+hi*1024+r32*16;
  const int vb0=(int)(lds0+DS_V)+((lane>>4)&1)*32+(lane&3)*8+(4*hi+((lane&15)>>2))*64;
  const int qrel=wid*QBLK+r32;
  #define DS_ISSUE(X,t,sl) do{ const int ks_=64*(t)*UPc*(X).d; \
    glds16((X).K0+ks_,kvo1*(unsigned)(X).d+kvoc,(unsigned)__builtin_amdgcn_readfirstlane(kdst+(sl)*8192)); \
    glds16((X).V0+ks_,vvo1*(unsigned)(X).d+vvoc,(unsigned)__builtin_amdgcn_readfirstlane(vdst+(sl)*8192)); }while(0)
  #define SLOT(map,t) (((map)>>(4*(t)))&7)
  #define DS_LOADQ(X) do{ const bf16*Qw_=(X).Q0+(wid*QBLK+r32)*(UPc*(X).d); _Pragma("unroll") for(int d0=0;d0<4;++d0)qr[d0]=*reinterpret_cast<const bf16x8*>(Qw_+d0*16+hi*8); }while(0)
  #define PKW(P,B) cvtpk_s(P[B],P[B+1])
  #define PAF(k) __builtin_bit_cast(bf16x8,pw##k)
  DswaUnit cur=dswa_desc(ubase,U,OA,LSE);
  bf16x8 qr[4]; bf16x8 kf[8]; u32x4 pw0,pw1,pw2,pw3; f32x16 p0,p1;
  #pragma unroll
  for(int t=0;t<6;++t)DS_ISSUE(cur,t,t);
  unsigned smap=0x543210u;
  DS_LOADQ(cur);
  for(int ui=0;ui<nunits;++ui){
    const bool has_next=ui+1<nunits;
    DswaUnit nxt=cur; if(has_next)nxt=dswa_desc(ubase+ui+1,U,OA,LSE);
    const bool chain=has_next&&cur.chain!=0; const int nt0=chain?2:0;
    const unsigned nmap=chain?(((smap>>16)&0xffu)|((smap&0xffffu)<<8)):smap;
    const int t_a=wid>>1, t_min=cur.kmin>>6, t_lo=t_a<t_min?t_min:t_a;
    const int mlo=cur.kmin-qrel, lo_=mlo<0?0:mlo;
    float mhat=0.f,l_reg=0.f; f32x16 o[2]; o[0]=f32x16{}; o[1]=f32x16{}; f32x16 negm=f32x16{}; asm volatile("":"+v"(negm));
    #pragma unroll
    for(int j=0;j<3;++j){
      const int s=t_a+j;
      wait_vm(j==0?4:((j==1||has_next)?2:0));
      asm volatile("s_waitcnt lgkmcnt(0)\n\ts_barrier":::"memory");
      if(has_next&&j>0)DS_ISSUE(nxt,nt0+j-1,SLOT(smap,j-1));
      if(s>=t_lo){
        kload8(kf,kp0+SLOT(smap,s)*8192);
        p0=__builtin_amdgcn_mfma_f32_32x32x16_bf16(kf[0],qr[0],negm,0,0,0);p1=__builtin_amdgcn_mfma_f32_32x32x16_bf16(kf[1],qr[0],negm,0,0,0);
        p0=__builtin_amdgcn_mfma_f32_32x32x16_bf16(kf[2],qr[1],p0,0,0,0);p1=__builtin_amdgcn_mfma_f32_32x32x16_bf16(kf[3],qr[1],p1,0,0,0);
        p0=__builtin_amdgcn_mfma_f32_32x32x16_bf16(kf[4],qr[2],p0,0,0,0);p1=__builtin_amdgcn_mfma_f32_32x32x16_bf16(kf[5],qr[2],p1,0,0,0);
        p0=__builtin_amdgcn_mfma_f32_32x32x16_bf16(kf[6],qr[3],p0,0,0,0);p1=__builtin_amdgcn_mfma_f32_32x32x16_bf16(kf[7],qr[3],p1,0,0,0);
        asm volatile("s_nop 15\n\ts_nop 7":"+v"(p0),"+v"(p1));
        if(j!=1||cur.kmin!=0){ const int kb=64*s+4*hi-qrel-lo_; const unsigned span=(unsigned)(128-lo_);
          #pragma unroll
          for(int r=0;r<16;++r){ const int dv=kb+(r&3)+8*(r>>2); if((unsigned)dv>span)p0[r]=-INFINITY; if((unsigned)(dv+32)>span)p1[r]=-INFINITY; } }
        const float rm=rowmax(p0,p1); bool resc=false;
        if(s==t_lo){ const float dl=(rm<-1e30f)?0.f:rm; mhat+=dl;
          #pragma unroll
          for(int r=0;r<16;++r){p0[r]-=dl;p1[r]-=dl;}
          #pragma unroll
          for(int r=0;r<16;++r)negm[r]=-mhat;
          asm volatile("":"+v"(negm)); }
        else if(__any(rm>(float)THRL)){ const float dl=__builtin_fmaxf(rm,0.f); mhat+=dl;
          #pragma unroll
          for(int r=0;r<16;++r){p0[r]-=dl;p1[r]-=dl;}
          #pragma unroll
          for(int r=0;r<16;++r)negm[r]=-mhat;
          asm volatile("":"+v"(negm));
          const float f=__builtin_amdgcn_exp2f(-dl); l_reg*=f; if(hi==0)wsf[r32]=f; resc=true; }
        #pragma unroll
        for(int r=0;r<16;++r){p0[r]=__builtin_amdgcn_exp2f(p0[r]);p1[r]=__builtin_amdgcn_exp2f(p1[r]);}
        if(resc){ asm volatile("s_waitcnt lgkmcnt(0)":::"memory");
          #pragma unroll
          for(int r=0;r<16;++r){ const float f_=wsf[crow(r,hi)]; o[0][r]*=f_; o[1][r]*=f_; } }
        { float sacc=p0[0]+p0[1];
          #pragma unroll
          for(int r=2;r<16;++r)sacc+=p0[r];
          #pragma unroll
          for(int r=0;r<16;++r)sacc+=p1[r];
          l_reg+=sacc; }
        pw0=(u32x4){PKW(p0,0),PKW(p0,2),PKW(p0,4),PKW(p0,6)};pw1=(u32x4){PKW(p0,8),PKW(p0,10),PKW(p0,12),PKW(p0,14)};pw2=(u32x4){PKW(p1,0),PKW(p1,2),PKW(p1,4),PKW(p1,6)};pw3=(u32x4){PKW(p1,8),PKW(p1,10),PKW(p1,12),PKW(p1,14)};
        pv(o,vb0+SLOT(smap,s)*8192,PAF(0),PAF(1),PAF(2),PAF(3));
      }
    }
    const DswaUnit fin=cur;
    asm volatile("s_waitcnt lgkmcnt(0)\n\ts_barrier":::"memory");
    if(has_next)DS_LOADQ(nxt);
    {auto rr=__builtin_amdgcn_permlane32_swap(__float_as_uint(l_reg),__float_as_uint(l_reg),false,false);l_reg=__uint_as_float(rr[0])+__uint_as_float(rr[1]);}
    if(hi==0){wsf[32+r32]=l_reg; fin.ls[(wid*QBLK+r32)*(8*fin.d)]=mhat+__builtin_amdgcn_logf(l_reg);}asm volatile("s_waitcnt lgkmcnt(0)":::"memory");
    float rli[16];
    #pragma unroll
    for(int r=0;r<16;++r)rli[r]=__builtin_amdgcn_rcpf(wsf[32+crow(r,hi)]);
    { bf16*Ow=fin.O0+(wid*QBLK)*(512*fin.d); bf16*stg=(bf16*)(shm+DS_OST)+wid*2048;
      #pragma unroll
      for(int r=0;r<16;++r){const int orow=crow(r,hi);
        #pragma unroll
        for(int d0=0;d0<2;++d0)stg[orow*64+d0*32+r32]=__float2bfloat16(o[d0][r]*rli[r]);}
      asm volatile("s_waitcnt lgkmcnt(0)":::"memory");
      #pragma unroll
      for(int i=0;i<4;++i){const int row=i*8+(lane>>3),ch=lane&7; const u32x4 v=*(const u32x4*)(stg+row*64+ch*8); *(u32x4*)(Ow+row*(512*fin.d)+ch*8)=v;} }
    asm volatile("":::"memory");
    if(has_next){ if(chain){ DS_ISSUE(nxt,4,SLOT(smap,2)); DS_ISSUE(nxt,5,SLOT(smap,3)); } else { DS_ISSUE(nxt,2,SLOT(smap,2)); DS_ISSUE(nxt,3,SLOT(smap,3)); DS_ISSUE(nxt,4,SLOT(smap,4)); DS_ISSUE(nxt,5,SLOT(smap,5)); } }
    cur=nxt; smap=nmap;
  }
  asm volatile("s_waitcnt vmcnt(0)":::"memory");
  #undef DS_ISSUE
  #undef SLOT
  #undef DS_LOADQ
  #undef PKW
  #undef PAF
}
constexpr int ATTN_LDS_BYTES=LDS2_BYTES;
#undef SBAR
#undef WAIT_BAR
}
namespace cg = cooperative_groups;
constexpr int NWAVES = 8;
#ifndef MK_N_LAUNCHES
#define MK_N_LAUNCHES 1
#endif
constexpr int NPHASE = 11;
constexpr int SEQ = 8192, DM = 1024, M = 16384, INC = 4096, PLE = 256, UP = 3072;
constexpr size_t MiB = 1u << 20;
constexpr size_t WS_ROPE = 1 * MiB, WS_SSQA = WS_ROPE + 512 * 1024, WS_LSE = WS_SSQA + 1 * MiB;
constexpr size_t WS_WIN = 4 * MiB, WS_WOUT = 20 * MiB, WS_WGATE = 24 * MiB, WS_WPLE = 28 * MiB, WS_SSQB = 29 * MiB;
constexpr size_t WS_PB = 30 * MiB, WS_HB2 = 46 * MiB, WS_GATE = 78 * MiB, WS_OA = 110 * MiB, WS_U = 158 * MiB, WS_END = 254 * MiB;
constexpr size_t WS_OD = WS_HB2, WS_E = WS_U, WS_HB1 = WS_U + 32 * MiB;
static_assert(WS_LSE + 3 * (size_t)M * 8 * 4 <= WS_WIN && WS_U + (size_t)M * UP * 2 == WS_END, "d_ws map");
constexpr int LDS_BYTES = 155648;
#ifndef REP_PRO
#define REP_PRO 1
#endif
#ifndef REP_G1
#define REP_G1 1
#endif
#ifndef REP_DIFF
#define REP_DIFF 1
#endif
#ifndef REP_DSWA
#define REP_DSWA 1
#endif
#ifndef REP_G2
#define REP_G2 1
#endif
#ifndef REP_G3D
#define REP_G3D 0
#endif
#ifndef REP_E
#define REP_E 1
#endif

#define GAS __attribute__((address_space(1)))
#define LAS __attribute__((address_space(3)))
typedef unsigned short bf16;
typedef unsigned v4u __attribute__((ext_vector_type(4)));
typedef float f32x4 __attribute__((ext_vector_type(4)));
#define LDS_WAIT() asm volatile("s_waitcnt lgkmcnt(0)" ::: "memory")
__device__ __forceinline__ unsigned f2bf(float f) { unsigned u = __builtin_bit_cast(unsigned, f); return (u + 0x7fffu + ((u >> 16) & 1u)) >> 16; }
__device__ __forceinline__ unsigned pk2(float lo, float hi) { return f2bf(lo) | (f2bf(hi) << 16); }
__device__ __forceinline__ float bflo(unsigned u) { return __uint_as_float(u << 16); }
__device__ __forceinline__ float bfhi(unsigned u) { return __uint_as_float(u & 0xffff0000u); }
__device__ __forceinline__ float wave_sum(float v) {
#pragma unroll
    for (int o = 1; o < 64; o <<= 1) v += __shfl_xor(v, o);
    return v;
}
typedef GAS unsigned gu32;
#define RLX_AGENT __ATOMIC_RELAXED, __HIP_MEMORY_SCOPE_AGENT
constexpr int RSL_OFF = 133120, ROPEL_OFF = RSL_OFF + 1024, MISC_OFF = ROPEL_OFF + 16384;
constexpr size_t WS_CTL = 0, CTL_ZERO_BYTES = 65536;
#define XB_TMO      128
#define XB_XCNT(j)  (256  + 64 * (j))
#define XB_XSUB(j)  (1280 + 64 * (j))
#define XB_XGEN(j)  (2304 + 64 * (j))
#define XB_TOP      3328
#define XB_TOPGEN   3392
#define XCD_BAR_WORDS 3456
#define XB_SPIN_CAP (1u << 18)

__device__ __forceinline__ unsigned xb_ld(unsigned* p)              { return __hip_atomic_load(p, __ATOMIC_RELAXED, __HIP_MEMORY_SCOPE_AGENT); }
__device__ __forceinline__ unsigned xb_add(unsigned* p, unsigned v) { return __hip_atomic_fetch_add(p, v, __ATOMIC_RELAXED, __HIP_MEMORY_SCOPE_AGENT); }
__device__ __forceinline__ unsigned xb_xcc_id() { return (unsigned)__builtin_amdgcn_s_getreg((3 << 11) | 20) & 0xFu; }
#define XB_SPIN(cond, bar) do { unsigned _sp = 0; while (cond) { __builtin_amdgcn_s_sleep(1); \
    if ((++_sp & 255u) == 0u) { if (xb_ld(&(bar)[XB_TMO])) break; if (_sp > XB_SPIN_CAP) { atomicAdd(&(bar)[XB_TMO], 1u); break; } } } } while (0)

struct XcdBarrier {
    unsigned* bar; unsigned x;
    volatile LAS unsigned* st;
};

__device__ __forceinline__ XcdBarrier xcd_barrier_post(unsigned* bar, volatile LAS unsigned* st) {
    XcdBarrier b; b.bar = bar; b.x = xb_xcc_id(); b.st = st;
    if (threadIdx.x == 0) (void)xb_add(&bar[XB_XCNT(b.x)], 1u);
    return b;
}
__device__ __forceinline__ void xcd_barrier_complete(unsigned* bar, unsigned x, unsigned& nloc, unsigned& nx) {
    const unsigned G = gridDim.x * gridDim.y * gridDim.z;
    unsigned sum, cnt, mine, sp = 0u;
    for (;;) {
        sum = 0u; cnt = 0u; mine = 0u;
#pragma unroll
        for (unsigned j = 0; j < 16; ++j) { const unsigned c = xb_ld(&bar[XB_XCNT(j)]); sum += c; cnt += (c > 0u) ? 1u : 0u; mine = (j == x) ? c : mine; }
        if (sum == G) break;
        __builtin_amdgcn_s_sleep(1);
        if ((++sp & 255u) == 0u) { if (xb_ld(&bar[XB_TMO])) break; if (sp > XB_SPIN_CAP) { atomicAdd(&bar[XB_TMO], 1u); break; } }
    }
    nloc = mine > 0u ? mine : 1u; nx = cnt > 0u ? cnt : 1u;
}

__device__ __forceinline__ void xcd_barrier(const XcdBarrier& b) {
    asm volatile("s_waitcnt vmcnt(0)" ::: "memory");
    __syncthreads();
    if (threadIdx.x == 0) {
        unsigned* bar = b.bar;
        __builtin_amdgcn_s_waitcnt(0);
        unsigned nloc = b.st[0], nx = b.st[1];
        if (nloc == 0u) { xcd_barrier_complete(bar, b.x, nloc, nx); b.st[0] = nloc; b.st[1] = nx; }
        const unsigned old = xb_add(&bar[XB_XSUB(b.x)], 1u);
        const unsigned gen = old / nloc;
        if (old + 1u == (gen + 1u) * nloc) {
            __builtin_amdgcn_fence(__ATOMIC_RELEASE, "agent");
            asm volatile("s_waitcnt vmcnt(0)" ::: "memory");
            const unsigned og = xb_add(&bar[XB_TOP], 1u);
            const unsigned tg = og / nx;
            if (og + 1u == (tg + 1u) * nx) xb_add(&bar[XB_TOPGEN], 1u);
            else XB_SPIN(xb_ld(&bar[XB_TOPGEN]) == tg, bar);
            __builtin_amdgcn_fence(__ATOMIC_ACQUIRE, "agent");
            xb_add(&bar[XB_XGEN(b.x)], 1u);
            asm volatile("s_waitcnt vmcnt(0)" ::: "memory");
        } else {
            XB_SPIN(xb_ld(&bar[XB_XGEN(b.x)]) == gen, bar);
            __builtin_amdgcn_fence(__ATOMIC_ACQUIRE, "agent");
            asm volatile("s_waitcnt vmcnt(0)" ::: "memory");
        }
    }
    __syncthreads();
}

__device__ __forceinline__ void p0_transpose_item(const float* W, const float* gain, int K, int N, bf16* WT, LAS float* scr, int item, int lane, bool ropeperm = false) {
    const int nblk = N / 64, kb = item / nblk, nb = item % nblk, k0 = 32 * kb, n0 = 64 * nb;
    f32x4 v[8];
#pragma unroll
    for (int i = 0; i < 8; ++i) { const int kk = 4 * i + (lane >> 4); v[i] = *(const f32x4*)(W + (size_t)(k0 + kk) * N + n0 + (lane & 15) * 4); }
#pragma unroll
    for (int i = 0; i < 8; ++i) { const int kk = 4 * i + (lane >> 4); const float g = gain ? gain[k0 + kk] : 1.0f; LAS float* d = scr + kk * 65 + (lane & 15) * 4;
        d[0] = g * v[i][0]; d[1] = g * v[i][1]; d[2] = g * v[i][2]; d[3] = g * v[i][3]; }
    LDS_WAIT(); asm volatile("" ::: "memory");
    const int c = lane & 3;
#pragma unroll
    for (int j = 0; j < 4; ++j) { const int n = (lane >> 2) + 16 * j; const LAS float* s = scr + (8 * c) * 65 + n;
        v4u o; o.x = pk2(s[0 * 65], s[1 * 65]); o.y = pk2(s[2 * 65], s[3 * 65]); o.z = pk2(s[4 * 65], s[5 * 65]); o.w = pk2(s[6 * 65], s[7 * 65]);
        const int np = (ropeperm && n < 16) ? ((n < 8) ? 2 * n : 2 * (n - 8) + 1) : n;
        *(GAS v4u*)(WT + (size_t)(n0 + np) * K + k0 + 8 * c) = o; }
    LDS_WAIT(); asm volatile("" ::: "memory");
}

struct BalancedOrder : pg8::StaticOrder {
    __device__ bool next(int i, pg8::Unit& u) const { const bool r = pg8::StaticOrder::next(i, u); if (r && u.pn >= 4 && u.pn < 12) u.pn ^= 2; return r; }
};
struct Args { const float* in[14]; float* out; unsigned char* ws; int ph_lo, ph_hi; };
static_assert(sizeof(Args) == 14 * 8 + 8 + 8 + 8, "Args has no padding");

__global__ void __launch_bounds__(NWAVES * 64, 2) hymba_fwd(Args args) {
    extern __shared__ __attribute__((aligned(16))) unsigned char lds[];
    typedef const __attribute__((address_space(4))) Args* kargp_t;
    kargp_t KA = (kargp_t)__builtin_amdgcn_kernarg_segment_ptr();
#define PTRS() asm volatile("" : "+s"(KA)); unsigned char* ws = KA->ws; \
    int tid = threadIdx.x; asm volatile("" : "+v"(tid)); const int lane = tid & 63, wave = __builtin_amdgcn_readfirstlane(tid >> 6); \
    const int G = gridDim.x; const int bx = blockIdx.x; const int vcu = (G % 8 == 0) ? (bx % 8) * (G / 8) + bx / 8 : bx; const int gw = vcu * NWAVES + wave, NGW = G * NWAVES; (void)lane; (void)gw; (void)NGW; \
    const float* x = KA->in[0]; const float* p = KA->in[1]; const float* attn_g = KA->in[2]; const float* w_in = KA->in[3]; const float* w_out = KA->in[4]; \
    const float* lq1 = KA->in[5]; const float* lk1 = KA->in[6]; const float* lq2 = KA->in[7]; const float* lk2 = KA->in[8]; const float* subln_g = KA->in[9]; \
    const float* ple_g = KA->in[10]; const float* w_gate = KA->in[11]; const float* w_ple = KA->in[12]; const float* final_g = KA->in[13]; \
    float* H = KA->out; \
    float* ROPE = (float*)(ws + WS_ROPE); float* SSQA = (float*)(ws + WS_SSQA); float* SSQB = (float*)(ws + WS_SSQB); float* LSE = (float*)(ws + WS_LSE); \
    bf16* WIN = (bf16*)(ws + WS_WIN); bf16* WOUT = (bf16*)(ws + WS_WOUT); bf16* WGATE = (bf16*)(ws + WS_WGATE); bf16* WPLE = (bf16*)(ws + WS_WPLE); \
    bf16* PB = (bf16*)(ws + WS_PB); bf16* HB2 = (bf16*)(ws + WS_HB2); bf16* HB1 = (bf16*)(ws + WS_HB1); bf16* GATE = (bf16*)(ws + WS_GATE); \
    bf16* OA = (bf16*)(ws + WS_OA); bf16* OD = (bf16*)H;     bf16* U = (bf16*)(ws + WS_U); bf16* EB = (bf16*)(ws + WS_E); \
    (void)x; (void)p; (void)attn_g; (void)w_in; (void)w_out; (void)lq1; (void)lk1; (void)lq2; (void)lk2; (void)subln_g; (void)ple_g; (void)w_gate; (void)w_ple; (void)final_g; (void)H; \
    (void)ROPE; (void)SSQA; (void)SSQB; (void)LSE; (void)WIN; (void)WOUT; (void)WGATE; (void)WPLE; (void)PB; (void)HB2; (void)HB1; (void)GATE; (void)OA; (void)OD; (void)U; (void)EB
    const int lo = KA->ph_lo, hi = KA->ph_hi;
    { volatile LAS unsigned* M0 = (volatile LAS unsigned*)((LAS unsigned char*)lds + MISC_OFF); if (threadIdx.x < 32) M0[threadIdx.x] = 0u; }
    __syncthreads();
    XcdBarrier bar = xcd_barrier_post((unsigned*)(KA->ws + WS_CTL) + 1024, (volatile LAS unsigned*)((LAS unsigned char*)lds + MISC_OFF) + 8);
#define IN(k) (lo <= (k) && (k) < hi)
#define SEAM(k) do { if (IN(k) && IN((k) + 1)) xcd_barrier(bar); } while (0)

    if (IN(0)) for (int rep = 0; rep < REP_PRO; ++rep) { PTRS();
        LAS float* scr = (LAS float*)((LAS unsigned char*)lds + wave * 16384);
        constexpr int I_IN = (DM / 32) * (INC / 64), I_SQ = (DM / 32) * (DM / 64), I_PL = (PLE / 32) * (DM / 64), I_L = I_IN + 2 * I_SQ + I_PL;
        for (int it = gw; it < 2 * I_L; it += NGW) {
            const int l = it / I_L; int r = it % I_L;
            if (r < I_IN) { const int n0_ = 64 * (r % (INC / 64)); p0_transpose_item(w_in + (size_t)l * DM * INC, attn_g + l * DM, DM, INC, WIN + (size_t)l * DM * INC, scr, r, lane, (n0_ & 2047) < 1024); continue; } r -= I_IN;
            if (r < I_SQ) { p0_transpose_item(w_out + (size_t)l * DM * DM, nullptr, DM, DM, WOUT + (size_t)l * DM * DM, scr, r, lane); continue; } r -= I_SQ;
            if (r < I_SQ) { p0_transpose_item(w_gate + (size_t)l * DM * DM, ple_g + l * DM, DM, DM, WGATE + (size_t)l * DM * DM, scr, r, lane); continue; } r -= I_SQ;
            p0_transpose_item(w_ple + (size_t)l * PLE * DM, nullptr, PLE, DM, WPLE + (size_t)l * PLE * DM, scr, r, lane);
        }
        for (int m0 = gw; m0 < M; m0 += 4 * NGW) {
            f32x4 v[4][4];
#pragma unroll
            for (int q = 0; q < 4; ++q) { const int m = m0 + q * NGW; const f32x4* xr = (const f32x4*)(x + (size_t)(m < M ? m : m0) * DM) + lane;
#pragma unroll
                for (int j = 0; j < 4; ++j) v[q][j] = xr[64 * j]; }
#pragma unroll
            for (int q = 0; q < 4; ++q) { const int m = m0 + q * NGW; if (m < M) {
                unsigned long long* o8 = (unsigned long long*)(HB2 + (size_t)m * DM) + lane; float s = 0.f;
#pragma unroll
                for (int j = 0; j < 4; ++j) { const f32x4 w = v[q][j]; s += (w[0] * w[0] + w[1] * w[1]) + (w[2] * w[2] + w[3] * w[3]); o8[64 * j] = (unsigned long long)pk2(w[0], w[1]) | ((unsigned long long)pk2(w[2], w[3]) << 32); }
                s = wave_sum(s);
                if (lane < 16) SSQA[(size_t)m * 16 + lane] = lane == 0 ? s : 0.f; } }
        }
        { const size_t NI = (size_t)2 * M * PLE / 8, ST = (size_t)NGW * 64;
          for (size_t i0 = (size_t)gw * 64 + lane; i0 < NI; i0 += 4 * ST) {
            f32x4 a[4], b[4];
#pragma unroll
            for (int q = 0; q < 4; ++q) { const size_t i = i0 + q * ST < NI ? i0 + q * ST : i0; a[q] = ((const f32x4*)p)[2 * i]; b[q] = ((const f32x4*)p)[2 * i + 1]; }
#pragma unroll
            for (int q = 0; q < 4; ++q) { const size_t i = i0 + q * ST; if (i < NI) { v4u o; o.x = pk2(a[q][0], a[q][1]); o.y = pk2(a[q][2], a[q][3]); o.z = pk2(b[q][0], b[q][1]); o.w = pk2(b[q][2], b[q][3]); ((v4u*)PB)[i] = o; } }
          } }
        for (int i = gw * 64 + lane; i < SEQ * 8; i += NGW * 64) {
            const int pos = i >> 3, c = i & 7;
            const float inv = c == 0 ? 1.0f : c == 1 ? 0.19392274474868576f : c == 2 ? 0.03760603093086393f : c == 3 ? 0.007292664737217109f : c == 4 ? 0.001414213562373095f : c == 5 ? 0.0002742481756762073f : c == 6 ? 5.318295896944988e-05f : 1.031338537721246e-05f;
            const float ang = (float)pos * inv;
            const double rev = (double)ang * 0.15915494309189535; const float fr = (float)(rev - __builtin_rint(rev));
            ROPE[pos * 16 + c] = __builtin_amdgcn_cosf(fr); ROPE[pos * 16 + 8 + c] = __builtin_amdgcn_sinf(fr);
        }
    }
    SEAM(0);

auto layer = [&](auto LC) __attribute__((always_inline)) {
        constexpr int l = decltype(LC)::value;
        constexpr int P = 1 + 5 * l;
        if (IN(P)) for (int rep = 0; rep < REP_G1; ++rep) { PTRS();
            pg8::Gemm g{HB2, WIN + (size_t)l * DM * INC, M, INC, DM}; BalancedOrder S; S.init(M, INC, G, bx);
            LAS float* rsl = (LAS float*)((LAS unsigned char*)lds + RSL_OFF);
            { pg8::Unit u0; S.next(0, u0); pg8::Unit u3; const bool same = !S.next(3, u3) || u3.pm == u0.pm; (void)same;
              if (tid < 256) rsl[tid] = pg8::rstd_of(SSQA + (size_t)(u0.pm * 256 + tid) * 16);
              { const int rr = tid & 255, hf = tid >> 8; const f32x4* src = (const f32x4*)(ROPE + (size_t)((u0.pm * 256 + rr) & 8191) * 16 + hf * 8); LAS f32x4* dst = (LAS f32x4*)((LAS unsigned char*)lds + ROPEL_OFF) + rr * 4 + hf * 2; dst[0] = src[0]; dst[1] = src[1]; }
              __syncthreads(); }
            pg8::EpiQKVG E{U, GATE, rsl, (LAS float*)((LAS unsigned char*)lds + ROPEL_OFF)};
            pg8::gemm_phase<pg8::EpiQKVG, BalancedOrder, PG8_ALIGN, PG8_SP2>((LAS unsigned char*)lds, g, S, E);
        }
        SEAM(P);
        if (IN(P + 1)) { PTRS();
            using abf = attn_body::bf16;
            for (int rep = 0; rep < REP_DIFF; ++rep) { const int bhc = vcu >> 4, s = vcu & 15, c = bhc & 1, h = (bhc >> 1) & 3, b = bhc >> 3;
              for (int i = 0; i < 2; ++i) { const int qb = (i == 0) ? s : 31 - s; const size_t rb = (size_t)b * SEQ, q0 = (size_t)qb * 256;
                  const abf* Q0 = (const abf*)U + (rb + q0) * UP + 1536 + h * 128 + c * 64; const abf* K0 = (const abf*)U + rb * UP + 2048 + h * 128 + c * 64; const abf* V0 = (const abf*)U + rb * UP + 2560 + h * 128;
                  abf* O0 = (abf*)OD + (size_t)c * M * 512 + (rb + q0) * 512 + h * 128;
                  attn_body::attn_unit128<8, UP, UP, 512>(Q0, K0, V0, O0, 4 * (qb + 1), (char*)lds); } }
            for (int rep = 0; rep < REP_DSWA; ++rep) attn_body::dswa_phase<8>((const abf*)U, (abf*)OA, LSE, vcu * 6, 6, (char*)lds);
        }
        SEAM(P + 1);
        if (IN(P + 2)) { PTRS();
            const float linit = l == 0 ? 0.2f : 0.35550906759096934f;
            const float s1 = wave_sum(lq1[l * 64 + lane] * lk1[l * 64 + lane]), s2 = wave_sum(lq2[l * 64 + lane] * lk2[l * 64 + lane]);
            const float lam = __expf(s1) - __expf(s2) + linit;
            const f32x4 sg0 = *(const f32x4*)(subln_g + l * 128 + (lane & 15) * 8), sg1 = *(const f32x4*)(subln_g + l * 128 + (lane & 15) * 8 + 4);
            for (int m = gw; m < M; m += NGW) {
                const int ha = lane >> 3;
                const float L0 = LSE[(size_t)m * 8 + ha], L1 = LSE[(size_t)M * 8 + (size_t)m * 8 + ha], L2 = LSE[(size_t)2 * M * 8 + (size_t)m * 8 + ha];
                const float Lm = fmaxf(L0, fmaxf(L1, L2)); float w0 = __builtin_amdgcn_exp2f(L0 - Lm), w1 = __builtin_amdgcn_exp2f(L1 - Lm), w2 = __builtin_amdgcn_exp2f(L2 - Lm);
                const float wi = __builtin_amdgcn_rcpf(w0 + w1 + w2); w0 *= wi; w1 *= wi; w2 *= wi;
                const v4u a0 = *(const v4u*)(OA + (size_t)m * 512 + lane * 8), a1 = *(const v4u*)(OA + (size_t)M * 512 + (size_t)m * 512 + lane * 8), a2 = *(const v4u*)(OA + (size_t)2 * M * 512 + (size_t)m * 512 + lane * 8);
                v4u* gp = (v4u*)(GATE + (size_t)m * DM + lane * 8); const v4u ga = *gp; v4u o;
#pragma unroll
                for (int j = 0; j < 4; ++j) { const float vl = (w0 * bflo(a0[j]) + w1 * bflo(a1[j]) + w2 * bflo(a2[j])) * bflo(ga[j]), vhh = (w0 * bfhi(a0[j]) + w1 * bfhi(a1[j]) + w2 * bfhi(a2[j])) * bfhi(ga[j]); o[j] = pk2(vl, vhh); }
                *gp = o;
                const v4u d0 = *(const v4u*)(OD + (size_t)m * 512 + lane * 8), d1 = *(const v4u*)(OD + (size_t)M * 512 + (size_t)m * 512 + lane * 8);
                v4u* gq = (v4u*)(GATE + (size_t)m * DM + 512 + lane * 8); const v4u gb = *gq;
                float dv[8]; float ss = 0.f;
#pragma unroll
                for (int j = 0; j < 4; ++j) { dv[2 * j] = bflo(d0[j]) - lam * bflo(d1[j]); dv[2 * j + 1] = bfhi(d0[j]) - lam * bfhi(d1[j]); ss += dv[2 * j] * dv[2 * j] + dv[2 * j + 1] * dv[2 * j + 1]; }
                ss += __shfl_xor(ss, 1); ss += __shfl_xor(ss, 2); ss += __shfl_xor(ss, 4); ss += __shfl_xor(ss, 8);
                const float rs = __builtin_amdgcn_rsqf(ss * (1.0f / 128.0f) + 1e-5f) * (1.0f - linit);
#pragma unroll
                for (int j = 0; j < 4; ++j) { const float g0 = j < 2 ? sg0[2 * j] : sg1[2 * j - 4], g1 = j < 2 ? sg0[2 * j + 1] : sg1[2 * j - 3]; o[j] = pk2(dv[2 * j] * rs * g0 * bflo(gb[j]), dv[2 * j + 1] * rs * g1 * bfhi(gb[j])); }
                *gq = o;
            }
        }
        SEAM(P + 2);
        if (IN(P + 3)) { PTRS();
            for (int rep = 0; rep < (l == 0 ? REP_G2 : 1); ++rep) { pg8::Gemm g{GATE, WOUT + (size_t)l * DM * DM, M, DM, DM}; pg8::StaticOrder S; S.init(M, DM, G, bx);
              pg8::EpiRes<l == 0> E{x, HB2, HB1, SSQB};
              pg8::gemm_phase<pg8::EpiRes<l == 0>, pg8::StaticOrder, PG8_ALIGN, PG8_SP2>((LAS unsigned char*)lds, g, S, E); }
            for (int rep = 0; rep < REP_E; ++rep) { pg8::Gemm g{PB + (size_t)l * M * PLE, WPLE + (size_t)l * PLE * DM, M, DM, PLE}; pg8::StaticOrder S; S.init(M, DM, G, bx);
              pg8::EpiE E{EB};
              pg8::gemm_phase<pg8::EpiE, pg8::StaticOrder, PG8_ALIGN, PG8_SP2>((LAS unsigned char*)lds, g, S, E); }
        }
        SEAM(P + 3);
        if (IN(P + 4)) { PTRS();
            pg8::Gemm g{HB1, WGATE + (size_t)l * DM * DM, M, DM, DM}; pg8::StaticOrder S; S.init(M, DM, G, bx);
            for (int rep = 0; rep < REP_G3D; ++rep) { pg8::EpiE E{OA}; pg8::gemm_phase<pg8::EpiE, pg8::StaticOrder, PG8_ALIGN, PG8_SP2>((LAS unsigned char*)lds, g, S, E); }
            if constexpr (l == 0) { pg8::EpiPle E{HB1, EB, HB2, SSQB, SSQA};
                pg8::gemm_phase<pg8::EpiPle, pg8::StaticOrder, PG8_ALIGN, PG8_SP2>((LAS unsigned char*)lds, g, S, E); }
            else {
                pg8::EpiPleFinal E{HB1, EB, SSQB, SSQA, (unsigned*)(ws + WS_CTL) + 8192, final_g, H};
                pg8::gemm_phase<pg8::EpiPleFinal, pg8::StaticOrder, false, PG8_SP2>((LAS unsigned char*)lds, g, S, E); }
        }
        if constexpr (l == 0) SEAM(P + 4);
    };
    layer(std::integral_constant<int, 0>{});
    layer(std::integral_constant<int, 1>{});
#undef IN
#undef SEAM
}

extern "C" void kernel_launch(void* const* d_in, const int* in_sizes, int n_in, void* d_out, int out_size, void* d_ws, size_t ws_size, hipStream_t stream) {
    static int grid = 0;
    if (grid == 0) {
        if (n_in != 14 || out_size != M * DM || ws_size < WS_END) { fprintf(stderr, "kernel_launch: unexpected shapes (n_in %d out %d ws %zu)\n", n_in, out_size, ws_size); grid = -1; return; }
        int dev = 0, cus = 0, per_cu = 0;
        hipGetDevice(&dev); hipDeviceGetAttribute(&cus, hipDeviceAttributeMultiprocessorCount, dev);
        if (hipFuncSetAttribute((const void*)hymba_fwd, hipFuncAttributeMaxDynamicSharedMemorySize, LDS_BYTES) != hipSuccess) { fprintf(stderr, "kernel_launch: hipFuncSetAttribute failed\n"); grid = -1; return; }
        if (hipOccupancyMaxActiveBlocksPerMultiprocessor(&per_cu, (const void*)hymba_fwd, NWAVES * 64, LDS_BYTES) != hipSuccess || per_cu < 1) { fprintf(stderr, "kernel_launch: occupancy query says %d\n", per_cu); per_cu = 1; }
        (void)hipGetLastError();
        grid = cus * (per_cu > 1 ? 1 : per_cu);
        fprintf(stderr, "kernel_launch: grid %d (cus %d, per_cu %d)\n", grid, cus, per_cu);
    }
    if (grid < 0) return;
    if (hipMemsetAsync((char*)d_ws + WS_CTL, 0, CTL_ZERO_BYTES, stream) != hipSuccess) { fprintf(stderr, "kernel_launch: memset failed\n"); return; }
    Args a{};
    for (int i = 0; i < 14; ++i) a.in[i] = (const float*)d_in[i];
    a.out = (float*)d_out; a.ws = (unsigned char*)d_ws;
    for (int li = 0; li < MK_N_LAUNCHES; ++li) {
        a.ph_lo = (MK_N_LAUNCHES == 1) ? 0 : li; a.ph_hi = (MK_N_LAUNCHES == 1) ? NPHASE : li + 1;
        void* kargs[] = {&a};
        const hipError_t le = hipLaunchCooperativeKernel((const void*)hymba_fwd, dim3(grid), dim3(NWAVES * 64), kargs, LDS_BYTES, stream);
        if (le != hipSuccess) { fprintf(stderr, "kernel_launch: launch %d failed: %s\n", li, hipGetErrorName(le)); break; }
    }
}
```
